# Optimizing an MI355X kernel written in HIP

```python
import math
import jax, jax.numpy as jnp
from jax import lax
import numpy as np

D_MODEL = 2048
BATCH = 4
SEQ = 8192
DEPTH = 1
DEC_BATCH = 32
DEC_SEQ = 64
PAST_LEN = 2048

CHUNK = 64
ATTN_WIDTH = D_MODEL // 2
SSM_WIDTH = D_MODEL - ATTN_WIDTH
N_HEADS = 8
HEAD_DIM = ATTN_WIDTH // (2 * N_HEADS)
V_DIM = 2 * HEAD_DIM
ROT_DIM = HEAD_DIM // 4
ROPE_THETA = 500000.0
SSM_GROUP = 16
N_SSM_GROUPS = SSM_WIDTH // SSM_GROUP
SSM_STATE = 64
IN_WIDTH = 3 * ATTN_WIDTH + SSM_WIDTH
D_FF = 4 * D_MODEL
Q_BLOCK = 128
EPS = 1e-6
NEG_INF = -1e30

kernel_name = "hymba_diffattn_s5_streaming_step"


def rms_norm(x, g):
    xf = x.astype(jnp.float32)
    y = xf * lax.rsqrt(jnp.mean(xf * xf, axis=-1, keepdims=True) + EPS)
    return (y * g.astype(jnp.float32)).astype(x.dtype)


def ada_modulation(c, w_ada, b_ada):
    m = jax.nn.silu(c) @ w_ada + b_ada
    return [t[:, None, :] for t in jnp.split(m, 6, axis=-1)]


def rope_tables(positions):
    inv = jnp.power(jnp.float32(ROPE_THETA), -jnp.arange(0, ROT_DIM, 2, dtype=jnp.float32) / ROT_DIM)
    ang = positions.astype(jnp.float32)[:, None] * inv[None, :]
    return jnp.cos(ang), jnp.sin(ang)


def apply_partial_rope(t, cos, sin):
    half = ROT_DIM // 2
    c = cos[None, :, None, None, :]
    s = sin[None, :, None, None, :]
    t1 = t[..., :half].astype(jnp.float32)
    t2 = t[..., half:ROT_DIM].astype(jnp.float32)
    rot = jnp.concatenate([t1 * c - t2 * s, t2 * c + t1 * s], axis=-1).astype(t.dtype)
    return jnp.concatenate([rot, t[..., ROT_DIM:]], axis=-1)


def diff_attend(q, k, v, lam, mask=None):
    s = jnp.einsum('bqhcd,bkhcd->bhcqk', q.astype(jnp.float32), k.astype(jnp.float32)) * (HEAD_DIM ** -0.5)
    if mask is not None:
        s = jnp.where(mask, s, NEG_INF)
    p = jax.nn.softmax(s, axis=-1)
    w = p[:, :, 0] - lam * p[:, :, 1]
    return jnp.einsum('bhqk,bkhd->bqhd', w, v.astype(jnp.float32))


def prompt_diff_attention(q, k, v, lam):
    bsz, seq = q.shape[:2]
    n_blk = seq // Q_BLOCK
    q_blocks = q.reshape(bsz, n_blk, Q_BLOCK, N_HEADS, 2, HEAD_DIM).swapaxes(0, 1)
    key_chunk = jnp.arange(seq, dtype=jnp.int32) // CHUNK

    def one_block(args):
        blk, q_blk = args
        q_chunk = (blk * Q_BLOCK + jnp.arange(Q_BLOCK, dtype=jnp.int32)) // CHUNK
        mask = key_chunk[None, :] <= q_chunk[:, None]
        return diff_attend(q_blk, k, v, lam, mask)

    o = lax.map(one_block, (jnp.arange(n_blk, dtype=jnp.int32), q_blocks))
    return o.swapaxes(0, 1).reshape(bsz, seq, N_HEADS, V_DIM)


def s5_discretize(lam_re, lam_im, log_dt, b_re, b_im):
    lam_re = lam_re.astype(jnp.float32)
    lam_im = lam_im.astype(jnp.float32)
    dt = jnp.exp(log_dt.astype(jnp.float32))[:, None]
    mag = jnp.exp(lam_re * dt)
    ar = mag * jnp.cos(lam_im * dt)
    ai = mag * jnp.sin(lam_im * dt)
    den = lam_re * lam_re + lam_im * lam_im
    f_re = ((ar - 1.0) * lam_re + ai * lam_im) / den
    f_im = (ai * lam_re - (ar - 1.0) * lam_im) / den
    b_re = b_re.astype(jnp.float32)
    b_im = b_im.astype(jnp.float32)
    bb_re = f_re[..., None] * b_re - f_im[..., None] * b_im
    bb_im = f_re[..., None] * b_im + f_im[..., None] * b_re
    return ar, ai, bb_re, bb_im


def complex_affine_combine(e1, e2):
    a1r, a1i, b1r, b1i = e1
    a2r, a2i, b2r, b2i = e2
    return (a2r * a1r - a2i * a1i,
            a2r * a1i + a2i * a1r,
            a2r * b1r - a2i * b1i + b2r,
            a2r * b1i + a2i * b1r + b2i)


def s5_block(h_re, h_im, u_blk, ar, ai, bb_re, bb_im, c_re, c_im):
    bu_re = jnp.einsum('blgh,gph->blgp', u_blk, bb_re)
    bu_im = jnp.einsum('blgh,gph->blgp', u_blk, bb_im)
    bu_re = bu_re.at[:, 0].add(ar * h_re - ai * h_im)
    bu_im = bu_im.at[:, 0].add(ar * h_im + ai * h_re)
    a_re = jnp.broadcast_to(ar, bu_re.shape)
    a_im = jnp.broadcast_to(ai, bu_im.shape)
    _, _, s_re, s_im = lax.associative_scan(complex_affine_combine, (a_re, a_im, bu_re, bu_im), axis=1)
    y = (jnp.einsum('blgp,ghp->blgh', s_re, c_re.astype(jnp.float32))
         - jnp.einsum('blgp,ghp->blgh', s_im, c_im.astype(jnp.float32)))
    return s_re[:, -1], s_im[:, -1], y


def s5_prompt_scan(u_g, h0_re, h0_im, disc, c_re, c_im):
    bsz, seq = u_g.shape[:2]
    n_chunks = seq // CHUNK
    u_c = u_g.reshape(bsz, n_chunks, CHUNK, N_SSM_GROUPS, SSM_GROUP).swapaxes(0, 1)

    def step(carry, u_blk):
        h_re, h_im, y = s5_block(carry[0], carry[1], u_blk, *disc, c_re, c_im)
        return (h_re, h_im), y

    (h_re, h_im), ys = lax.scan(step, (h0_re, h0_im), u_c)
    return h_re, h_im, ys.swapaxes(0, 1).reshape(bsz, seq, N_SSM_GROUPS, SSM_GROUP)


def hybrid_layer(x, c, positions, past_k, past_v, h0_re, h0_im, lam_init,
                 w_ada, b_ada, g_mix, w_in, lam_q1, lam_k1, lam_q2, lam_k2, g_subln,
                 ssm_lam_re, ssm_lam_im, ssm_log_dt, ssm_b_re, ssm_b_im, ssm_c_re, ssm_c_im,
                 ssm_d, w_glu, b_glu, w_out, g_ffn, w_ff1, w_ff2):
    first_chunk = past_k is None
    bsz, seq, _ = x.shape
    shift1, scale1, gate1, shift2, scale2, gate2 = ada_modulation(c, w_ada, b_ada)

    h = rms_norm(x, g_mix) * (1.0 + scale1) + shift1
    proj = h @ w_in
    q, k, v, u = jnp.split(proj, [ATTN_WIDTH, 2 * ATTN_WIDTH, 3 * ATTN_WIDTH], axis=-1)

    cos, sin = rope_tables(positions)
    q = apply_partial_rope(q.reshape(bsz, seq, N_HEADS, 2, HEAD_DIM), cos, sin)
    k = apply_partial_rope(k.reshape(bsz, seq, N_HEADS, 2, HEAD_DIM), cos, sin)
    v = v.reshape(bsz, seq, N_HEADS, V_DIM)
    lam = (jnp.exp(jnp.sum(lam_q1.astype(jnp.float32) * lam_k1.astype(jnp.float32)))
           - jnp.exp(jnp.sum(lam_q2.astype(jnp.float32) * lam_k2.astype(jnp.float32)))
           + lam_init)
    if first_chunk:
        o = prompt_diff_attention(q, k, v, lam)
    else:
        o = diff_attend(q, jnp.concatenate([past_k, k.astype(past_k.dtype)], axis=1),
                        jnp.concatenate([past_v, v.astype(past_v.dtype)], axis=1), lam)
    o = rms_norm(o, g_subln) * (1.0 - lam_init)
    o = o.reshape(bsz, seq, ATTN_WIDTH).astype(x.dtype)

    disc = s5_discretize(ssm_lam_re, ssm_lam_im, ssm_log_dt, ssm_b_re, ssm_b_im)
    u_g = u.astype(jnp.float32).reshape(bsz, seq, N_SSM_GROUPS, SSM_GROUP)
    if first_chunk:
        zeros = jnp.zeros((bsz, N_SSM_GROUPS, SSM_STATE), jnp.float32)
        h_re, h_im, y_ssm = s5_prompt_scan(u_g, zeros, zeros, disc, ssm_c_re, ssm_c_im)
    else:
        h_re, h_im, y_ssm = s5_block(h0_re.astype(jnp.float32), h0_im.astype(jnp.float32),
                                     u_g, *disc, ssm_c_re, ssm_c_im)
    y_ssm = y_ssm + ssm_d.astype(jnp.float32).reshape(N_SSM_GROUPS, SSM_GROUP) * u_g
    z = jax.nn.gelu(y_ssm.reshape(bsz, seq, SSM_WIDTH)).astype(x.dtype)
    g = z @ w_glu + b_glu
    y_glu = g[..., :SSM_WIDTH] * jax.nn.sigmoid(g[..., SSM_WIDTH:])

    mix = jnp.concatenate([o, y_glu.astype(x.dtype)], axis=-1) @ w_out
    x = x + gate1 * mix

    h2 = rms_norm(x, g_ffn) * (1.0 + scale2) + shift2
    ff = jnp.square(jax.nn.relu(h2 @ w_ff1)) @ w_ff2
    x = x + gate2 * ff
    return x, k, v, h_re, h_im


def setup_inputs(seed: int = 0) -> dict:
    key = jax.random.key(seed)
    ks = iter(jax.random.split(key, 40))

    def nrm(shape, scale):
        return scale * jax.random.normal(next(ks), shape, jnp.float32)

    G, P, Hg = N_SSM_GROUPS, SSM_STATE, SSM_GROUP
    n_idx = jnp.arange(P, dtype=jnp.float32)
    return {
        "x_prompt": nrm((BATCH, SEQ, D_MODEL), 1.0),
        "x_sample": nrm((DEC_BATCH, DEC_SEQ, D_MODEL), 1.0),
        "c_prompt": nrm((BATCH, D_MODEL), 1.0),
        "c_sample": nrm((DEC_BATCH, D_MODEL), 1.0),
        "cache_k": nrm((DEPTH, DEC_BATCH, PAST_LEN, N_HEADS, 2, HEAD_DIM), 1.0),
        "cache_v": nrm((DEPTH, DEC_BATCH, PAST_LEN, N_HEADS, V_DIM), 1.0),
        "state_ssm_re": nrm((DEPTH, DEC_BATCH, G, P), 0.1),
        "state_ssm_im": nrm((DEPTH, DEC_BATCH, G, P), 0.1),
        "w_ada": nrm((DEPTH, D_MODEL, 6 * D_MODEL), 0.2 * D_MODEL ** -0.5),
        "b_ada": nrm((DEPTH, 6 * D_MODEL), 0.02),
        "g_mix": 1.0 + nrm((DEPTH, D_MODEL), 0.02),
        "w_in": nrm((DEPTH, D_MODEL, IN_WIDTH), D_MODEL ** -0.5),
        "lam_q1": nrm((DEPTH, HEAD_DIM), 0.1),
        "lam_k1": nrm((DEPTH, HEAD_DIM), 0.1),
        "lam_q2": nrm((DEPTH, HEAD_DIM), 0.1),
        "lam_k2": nrm((DEPTH, HEAD_DIM), 0.1),
        "g_subln": 1.0 + nrm((DEPTH, V_DIM), 0.02),
        "ssm_lam_re": -0.5 + nrm((DEPTH, G, P), 0.01),
        "ssm_lam_im": math.pi * n_idx + nrm((DEPTH, G, P), 0.01),
        "ssm_log_dt": jax.random.uniform(next(ks), (DEPTH, G), jnp.float32, math.log(1e-3), math.log(1e-1)),
        "ssm_b_re": nrm((DEPTH, G, P, Hg), (2 * Hg) ** -0.5),
        "ssm_b_im": nrm((DEPTH, G, P, Hg), (2 * Hg) ** -0.5),
        "ssm_c_re": nrm((DEPTH, G, Hg, P), (2 * P) ** -0.5),
        "ssm_c_im": nrm((DEPTH, G, Hg, P), (2 * P) ** -0.5),
        "ssm_d": nrm((DEPTH, SSM_WIDTH), 1.0),
        "w_glu": nrm((DEPTH, SSM_WIDTH, 2 * SSM_WIDTH), SSM_WIDTH ** -0.5),
        "b_glu": nrm((DEPTH, 2 * SSM_WIDTH), 0.02),
        "w_out": nrm((DEPTH, D_MODEL, D_MODEL), D_MODEL ** -0.5),
        "g_ffn": 1.0 + nrm((DEPTH, D_MODEL), 0.02),
        "w_ff1": nrm((DEPTH, D_MODEL, D_FF), D_MODEL ** -0.5),
        "w_ff2": nrm((DEPTH, D_FF, D_MODEL), D_FF ** -0.5),
        "g_final": 1.0 + nrm((D_MODEL,), 0.02),
    }


def reference(x_prompt, x_sample, c_prompt, c_sample, cache_k, cache_v, state_ssm_re, state_ssm_im,
              w_ada, b_ada, g_mix, w_in, lam_q1, lam_k1, lam_q2, lam_k2, g_subln,
              ssm_lam_re, ssm_lam_im, ssm_log_dt, ssm_b_re, ssm_b_im, ssm_c_re, ssm_c_im,
              ssm_d, w_glu, b_glu, w_out, g_ffn, w_ff1, w_ff2, g_final):
    xp, xs = x_prompt, x_sample
    pos_p = jnp.arange(xp.shape[1], dtype=jnp.int32)
    pos_s = cache_k.shape[2] + jnp.arange(xs.shape[1], dtype=jnp.int32)
    kp, vp, srp, sip, ksn, vsn, srs, sis = [], [], [], [], [], [], [], []
    for l in range(DEPTH):
        lam_init = 0.8 - 0.6 * math.exp(-0.3 * l)
        params = (w_ada[l], b_ada[l], g_mix[l], w_in[l], lam_q1[l], lam_k1[l], lam_q2[l], lam_k2[l],
                  g_subln[l], ssm_lam_re[l], ssm_lam_im[l], ssm_log_dt[l], ssm_b_re[l], ssm_b_im[l],
                  ssm_c_re[l], ssm_c_im[l], ssm_d[l], w_glu[l], b_glu[l], w_out[l], g_ffn[l],
                  w_ff1[l], w_ff2[l])
        xp, k_l, v_l, hr_l, hi_l = hybrid_layer(xp, c_prompt, pos_p, None, None, None, None,
                                                lam_init, *params)
        kp.append(k_l); vp.append(v_l); srp.append(hr_l); sip.append(hi_l)
        xs, k_l, v_l, hr_l, hi_l = hybrid_layer(xs, c_sample, pos_s, cache_k[l], cache_v[l],
                                                state_ssm_re[l], state_ssm_im[l], lam_init, *params)
        ksn.append(k_l); vsn.append(v_l); srs.append(hr_l); sis.append(hi_l)
    y_prompt = rms_norm(xp, g_final)
    y_sample = rms_norm(xs, g_final)
    return (y_prompt, y_sample,
            jnp.stack(kp), jnp.stack(vp), jnp.stack(srp), jnp.stack(sip),
            jnp.stack(ksn), jnp.stack(vsn), jnp.stack(srs), jnp.stack(sis))
```

```cpp
#include <hip/hip_runtime.h>
#include <cstdio>
#include <cstdint>
namespace pg8 {
#define PG8_LAS __attribute__((address_space(3)))
typedef unsigned short bf16_t;
typedef short bf16x8 __attribute__((ext_vector_type(8)));
typedef float f32x4 __attribute__((ext_vector_type(4)));
typedef unsigned u32x4 __attribute__((ext_vector_type(4)));
constexpr int BM = 256, BK = 64, HALF = 128, HTB = HALF * BK * 2  , STAGE_BYTES = 8 * HTB, NXCD = 8, WGM = 8;

__host__ __device__ __forceinline__ int lds_byte(int r, int c) { const int st = (r >> 4) * 2 + (c >> 5), rr = r & 15, cc = c & 31, ob = rr * 64 + cc * 2; return st * 1024 + (ob ^ (((ob >> 9) & 1) << 5)); }
__host__ __device__ __forceinline__ void stage_rc(int b, int& R, int& C) { const int st = b / 1024, sb = b % 1024, swz = sb ^ (((sb >> 9) & 1) << 5); R = (st >> 1) * 16 + swz / 64; C = (st & 1) * 32 + (swz % 64) / 2; }
__host__ __device__ __forceinline__ int perm32(int rho) { const int n = rho >> 4, i = rho & 15; return 8 * (i >> 2) + 4 * n + (i & 3); }

struct Unit { int pm, pn; };
struct Gemm { const bf16_t* A; const bf16_t* Bt; int lda, ldb, K; };

struct StaticOrder {
    int nM, nN, nwg, G, c;
    __host__ __device__ void init(int M, int N, int G_, int c_) { nM = M / BM; nN = N / BM; nwg = nM * nN; G = G_; c = c_; }
    __host__ __device__ bool next(int i, Unit& u) const {
        const long L = (long)i * G + c; if (L >= nwg) return false;
        int wgid = (int)L; { const int q = nwg / NXCD, r = nwg % NXCD, xcd = wgid % NXCD, off = wgid / NXCD; wgid = (xcd < r ? xcd * (q + 1) : r * (q + 1) + (xcd - r) * q) + off; }
        const int nig = WGM * nN, gid = wgid / nig, fm = gid * WGM, gsz = (nM - fm) < WGM ? (nM - fm) : WGM;
        u.pm = fm + ((wgid % nig) % gsz); u.pn = (wgid % nig) / gsz; return true;
    }
    __device__ __forceinline__ void a_ready(const Unit&) const {}
    __device__ __forceinline__ void done(const Unit&) const {}
};

__device__ __forceinline__ unsigned cvt_pk_bf16(float lo, float hi) { unsigned r; asm volatile("v_cvt_pk_bf16_f32 %0, %1, %2" : "=v"(r) : "v"(lo), "v"(hi)); return r; }
template <class Epi, class Sched, bool ALIGN_EPI = false, bool SP2 = false>
__device__ __forceinline__ void gemm_phase(PG8_LAS unsigned char* lds, const Gemm g, const Sched& S, const Epi& E) {
    int tid = threadIdx.x; asm volatile("" : "+v"(tid));
    const int wid = __builtin_amdgcn_readfirstlane(tid >> 6), lane = tid & 63, wr = wid >> 2, wc = wid & 3, fr = lane & 15, fq = lane >> 4;
    const int K = g.K, nt = K / BK;
    unsigned voffA[2], voffB[2];
#pragma unroll
    for (int i = 0; i < 2; ++i) { int R, C; stage_rc(tid * 16 + i * 8192, R, C); const int Rb = Epi::PERM ? ((R & ~31) + perm32(R & 31)) : R;
        voffA[i] = (unsigned)(R * g.lda + C) * 2u; voffB[i] = (unsigned)(Rb * g.ldb + C) * 2u; }
    const size_t kstep = (size_t)(BK * 2);
    const size_t hstepA = (size_t)HALF * g.lda * 2, hstepB = (size_t)HALF * g.ldb * 2;
    const size_t tstepA = 2 * hstepA, tstepB = 2 * hstepB;
    const unsigned ldsw = (unsigned)wid * 1024u;
    const int aoff = lds_byte(wr * 64 + fr, fq * 8), boff = lds_byte(wc * 32 + fr, fq * 8);
#define PG8_SA(b, h) (((b) * 2 + (h)) * HTB)
#define PG8_SB(b, h) ((4 + (b) * 2 + (h)) * HTB)
#define PG8_STAGE(bufoff, gbase, voff) do { _Pragma("unroll") for (int _i = 0; _i < 2; ++_i) \
        __builtin_amdgcn_global_load_lds((const unsigned*)((const char*)(gbase) + (voff)[_i]), (PG8_LAS unsigned*)(lds + (bufoff) + ldsw + _i * 8192), 16, 0, 0); } while (0)
#define PG8_LDA(dst, b, h) do { _Pragma("unroll") for (int m = 0; m < 4; ++m) _Pragma("unroll") for (int k = 0; k < 2; ++k) dst[m][k] = *(const PG8_LAS bf16x8*)(lds + PG8_SA(b, h) + aoff + m * 2048 + k * 1024); } while (0)
#define PG8_LDB(dst, b, h) do { _Pragma("unroll") for (int n = 0; n < 2; ++n) _Pragma("unroll") for (int k = 0; k < 2; ++k) dst[n][k] = *(const PG8_LAS bf16x8*)(lds + PG8_SB(b, h) + boff + n * 2048 + k * 1024); } while (0)
#define PG8_MMA(ai, bj, At, Bt) do { __builtin_amdgcn_s_setprio(1); _Pragma("unroll") for (int m = 0; m < 4; ++m) _Pragma("unroll") for (int n = 0; n < 2; ++n) _Pragma("unroll") for (int k = 0; k < 2; ++k) \
        acc[ai][bj][m][n] = __builtin_amdgcn_mfma_f32_16x16x32_bf16(Bt[n][k], At[m][k], acc[ai][bj][m][n], 0, 0, 0); __builtin_amdgcn_s_setprio(0); } while (0)
#define PG8_WAIT_V(n) asm volatile("s_waitcnt vmcnt(" #n ")" ::: "memory")
#define PG8_WAIT_L(n) asm volatile("s_waitcnt lgkmcnt(" #n ")" ::: "memory")
#define PG8_BAR __builtin_amdgcn_s_barrier()
#define PG8_SCHED __builtin_amdgcn_sched_barrier(0)
    Unit cur, nxt; int ui = 0;
    if (!S.next(0, cur)) return;
    f32x4 acc[2][2][4][2];
#pragma unroll
    for (int a = 0; a < 2; ++a)
#pragma unroll
        for (int b = 0; b < 2; ++b)
#pragma unroll
            for (int m = 0; m < 4; ++m)
#pragma unroll
                for (int n = 0; n < 2; ++n) acc[a][b][m][n] = (f32x4){0.f, 0.f, 0.f, 0.f};
    bf16x8 At[4][2], B0[2][2], B1[2][2];
    const char* cA = (const char*)g.A + (size_t)cur.pm * tstepA; const char* cB = (const char*)g.Bt + (size_t)cur.pn * tstepB;
    S.a_ready(cur);
    if constexpr (SP2) {
        PG8_STAGE(PG8_SB(0, 0), cB, voffB); PG8_STAGE(PG8_SB(0, 1), cB + hstepB, voffB); PG8_STAGE(PG8_SA(0, 0), cA, voffA); PG8_STAGE(PG8_SA(0, 1), cA + hstepA, voffA);
        if (wr == 1) PG8_BAR;
        PG8_WAIT_V(2); PG8_BAR;
        PG8_STAGE(PG8_SB(1, 0), cB + kstep, voffB); PG8_STAGE(PG8_SA(1, 0), cA + kstep, voffA); PG8_STAGE(PG8_SB(1, 1), cB + hstepB + kstep, voffB);
        PG8_WAIT_V(6); PG8_BAR;
    } else {
        PG8_STAGE(PG8_SB(0, 0), cB, voffB); PG8_STAGE(PG8_SA(0, 0), cA, voffA); PG8_STAGE(PG8_SB(0, 1), cB + hstepB, voffB); PG8_STAGE(PG8_SA(0, 1), cA + hstepA, voffA);
        if (wr == 1) PG8_BAR;
        PG8_WAIT_V(4); PG8_BAR;
        PG8_STAGE(PG8_SB(1, 0), cB + kstep, voffB); PG8_STAGE(PG8_SA(1, 0), cA + kstep, voffA); PG8_STAGE(PG8_SB(1, 1), cB + hstepB + kstep, voffB);
        PG8_WAIT_V(6); PG8_BAR;
    }
    for (;;) {
        const bool has_next = S.next(ui + 1, nxt);
        const char* nA = has_next ? (const char*)g.A + (size_t)nxt.pm * tstepA : cA; const char* nB = has_next ? (const char*)g.Bt + (size_t)nxt.pn * tstepB : cB;
#pragma unroll 1
        for (int t = 0; t < nt; t += 2) {
            const bool last = (t == nt - 2);
            const char* a1 = cA + (size_t)(t + 1) * kstep;
            const char* a2 = last ? nA : cA + (size_t)(t + 2) * kstep; const char* b2 = last ? nB : cB + (size_t)(t + 2) * kstep;
            const char* a3 = a2 + kstep; const char* b3 = b2 + kstep;
            if (last && has_next) S.a_ready(nxt);
            if constexpr (SP2) {
            PG8_LDB(B0, 0, 0); PG8_LDB(B1, 0, 1); PG8_SCHED; PG8_LDA(At, 0, 0); PG8_STAGE(PG8_SA(1, 1), a1 + hstepA, voffA);
            PG8_WAIT_V(8); PG8_WAIT_L(0); PG8_BAR; PG8_MMA(0, 0, At, B0); PG8_MMA(0, 1, At, B1); PG8_BAR; PG8_SCHED;
            PG8_LDA(At, 0, 1); PG8_STAGE(PG8_SB(0, 0), b2, voffB); PG8_STAGE(PG8_SB(0, 1), b2 + hstepB, voffB); PG8_STAGE(PG8_SA(0, 0), a2, voffA);
            PG8_WAIT_V(8); PG8_WAIT_L(0); PG8_BAR; PG8_MMA(1, 0, At, B0); PG8_MMA(1, 1, At, B1); PG8_BAR; PG8_SCHED;
            PG8_LDB(B0, 1, 0); PG8_LDB(B1, 1, 1); PG8_SCHED; PG8_LDA(At, 1, 0); PG8_STAGE(PG8_SA(0, 1), a2 + hstepA, voffA);
            PG8_WAIT_V(8); PG8_WAIT_L(0); PG8_BAR; PG8_MMA(0, 0, At, B0); PG8_MMA(0, 1, At, B1); PG8_BAR; PG8_SCHED;
            PG8_LDA(At, 1, 1); PG8_STAGE(PG8_SB(1, 0), b3, voffB); PG8_STAGE(PG8_SB(1, 1), b3 + hstepB, voffB); PG8_STAGE(PG8_SA(1, 0), a3, voffA);
            PG8_WAIT_V(8); PG8_WAIT_L(0); PG8_BAR; PG8_MMA(1, 0, At, B0); PG8_MMA(1, 1, At, B1); PG8_BAR; PG8_SCHED;
            } else {
            PG8_LDB(B0, 0, 0); PG8_SCHED; PG8_LDA(At, 0, 0); PG8_STAGE(PG8_SA(1, 1), a1 + hstepA, voffA);
            PG8_WAIT_L(8); PG8_BAR; PG8_WAIT_L(0); PG8_MMA(0, 0, At, B0); PG8_BAR; PG8_SCHED;
            PG8_LDB(B1, 0, 1); PG8_STAGE(PG8_SB(0, 0), b2, voffB);
            PG8_BAR; PG8_WAIT_L(0); PG8_MMA(0, 1, At, B1); PG8_BAR;
            PG8_LDA(At, 0, 1); PG8_STAGE(PG8_SA(0, 0), a2, voffA);
            PG8_BAR; PG8_WAIT_L(0); PG8_MMA(1, 0, At, B0); PG8_BAR; PG8_SCHED;
            PG8_STAGE(PG8_SB(0, 1), b2 + hstepB, voffB);
            PG8_WAIT_V(6); PG8_BAR; PG8_MMA(1, 1, At, B1); PG8_BAR;
            PG8_LDB(B0, 1, 0); PG8_SCHED; PG8_LDA(At, 1, 0); PG8_STAGE(PG8_SA(0, 1), a2 + hstepA, voffA);
            PG8_WAIT_L(8); PG8_BAR; PG8_WAIT_L(0); PG8_MMA(0, 0, At, B0); PG8_BAR; PG8_SCHED;
            PG8_LDB(B1, 1, 1); PG8_STAGE(PG8_SB(1, 0), b3, voffB);
            PG8_BAR; PG8_WAIT_L(0); PG8_MMA(0, 1, At, B1); PG8_BAR;
            PG8_LDA(At, 1, 1); PG8_STAGE(PG8_SA(1, 0), a3, voffA);
            PG8_BAR; PG8_WAIT_L(0); PG8_MMA(1, 0, At, B0); PG8_BAR; PG8_SCHED;
            PG8_STAGE(PG8_SB(1, 1), b3 + hstepB, voffB);
            PG8_WAIT_V(6); PG8_BAR; PG8_MMA(1, 1, At, B1); PG8_BAR;
            }
        }
        if constexpr (ALIGN_EPI) { if (wr == 0) PG8_BAR; }
        if constexpr (!Epi::AFTER_DRAIN) { E(acc, cur, wr, wc, fr, fq); S.done(cur); }
        if (!has_next) break;
#pragma unroll
        for (int a = 0; a < 2; ++a)
#pragma unroll
            for (int b = 0; b < 2; ++b)
#pragma unroll
                for (int m = 0; m < 4; ++m)
#pragma unroll
                    for (int n = 0; n < 2; ++n) acc[a][b][m][n] = (f32x4){0.f, 0.f, 0.f, 0.f};
        cur = nxt; cA = nA; cB = nB; ++ui;
        if constexpr (ALIGN_EPI) { if (wr == 1) PG8_BAR; }
    }
    PG8_WAIT_V(0);
    if constexpr (!ALIGN_EPI) { if (wr == 0) PG8_BAR; }
    PG8_BAR;
    if constexpr (Epi::AFTER_DRAIN) { E.fused(acc, cur, wr, wc, fr, fq, lds, wid, lane); S.done(cur); }
#undef PG8_SA
#undef PG8_SB
#undef PG8_STAGE
#undef PG8_LDA
#undef PG8_LDB
#undef PG8_MMA
#undef PG8_WAIT_V
#undef PG8_WAIT_L
#undef PG8_BAR
#undef PG8_SCHED
}
}
#define GAS __attribute__((address_space(1)))
#define LAS __attribute__((address_space(3)))
typedef unsigned short bf16;
typedef unsigned v4u __attribute__((ext_vector_type(4)));
typedef float f32x4 __attribute__((ext_vector_type(4)));
typedef short bf16x8 __attribute__((ext_vector_type(8)));
typedef GAS unsigned gu32;
typedef GAS unsigned long long gu64;
#define RLX_AGENT __ATOMIC_RELAXED, __HIP_MEMORY_SCOPE_AGENT
#define LDS_WAIT() asm volatile("s_waitcnt lgkmcnt(0)" ::: "memory")
#define VM_WAIT() asm volatile("s_waitcnt vmcnt(0)" ::: "memory")
__device__ __forceinline__ unsigned long long rt() { return __builtin_amdgcn_s_memrealtime(); }
__device__ __forceinline__ unsigned f2bf(float f) { unsigned u = __builtin_bit_cast(unsigned, f); return (u + 0x7fffu + ((u >> 16) & 1u)) >> 16; }
__device__ __forceinline__ unsigned pk2(float lo, float hi) { return f2bf(lo) | (f2bf(hi) << 16); }
#define XB_TMO      128
#define XB_XCNT(j)  (256  + 64 * (j))
#define XB_XSUB(j)  (1280 + 64 * (j))
#define XB_XGEN(j)  (2304 + 64 * (j))
#define XB_TOP      3328
#define XB_TOPGEN   3392
#define XCD_BAR_WORDS 3456
#define XB_SPIN_CAP (1u << 18)

__device__ __forceinline__ unsigned xb_ld(unsigned* p)              { return __hip_atomic_load(p, __ATOMIC_RELAXED, __HIP_MEMORY_SCOPE_AGENT); }
__device__ __forceinline__ unsigned xb_add(unsigned* p, unsigned v) { return __hip_atomic_fetch_add(p, v, __ATOMIC_RELAXED, __HIP_MEMORY_SCOPE_AGENT); }
__device__ __forceinline__ unsigned xb_xcc_id() { return (unsigned)__builtin_amdgcn_s_getreg((3 << 11) | 20) & 0xFu; }
#define XB_SPIN(cond, bar) do { unsigned _sp = 0; while (cond) { __builtin_amdgcn_s_sleep(1); \
    if ((++_sp & 255u) == 0u) { if (xb_ld(&(bar)[XB_TMO])) break; if (_sp > XB_SPIN_CAP) { atomicAdd(&(bar)[XB_TMO], 1u); break; } } } } while (0)

struct XcdBarrier {
    unsigned* bar; unsigned x;
    volatile LAS unsigned* st;
};

__device__ __forceinline__ XcdBarrier xcd_barrier_post(unsigned* bar, volatile LAS unsigned* st) {
    XcdBarrier b; b.bar = bar; b.x = xb_xcc_id(); b.st = st;
    if (threadIdx.x == 0) (void)xb_add(&bar[XB_XCNT(b.x)], 1u);
    return b;
}
__device__ __forceinline__ void xcd_barrier_complete(unsigned* bar, unsigned x, unsigned& nloc, unsigned& nx) {
    const unsigned G = gridDim.x * gridDim.y * gridDim.z;
    unsigned sum, cnt, mine, sp = 0u;
    for (;;) {
        sum = 0u; cnt = 0u; mine = 0u;
#pragma unroll
        for (unsigned j = 0; j < 16; ++j) { const unsigned c = xb_ld(&bar[XB_XCNT(j)]); sum += c; cnt += (c > 0u) ? 1u : 0u; mine = (j == x) ? c : mine; }
        if (sum == G) break;
        __builtin_amdgcn_s_sleep(1);
        if ((++sp & 255u) == 0u) { if (xb_ld(&bar[XB_TMO])) break; if (sp > XB_SPIN_CAP) { atomicAdd(&bar[XB_TMO], 1u); break; } }
    }
    nloc = mine > 0u ? mine : 1u; nx = cnt > 0u ? cnt : 1u;
}

__device__ __forceinline__ void xcd_barrier(const XcdBarrier& b) {
    asm volatile("s_waitcnt vmcnt(0)" ::: "memory");
    __syncthreads();
    if (threadIdx.x == 0) {
        unsigned* bar = b.bar;
        __builtin_amdgcn_s_waitcnt(0);
        unsigned nloc = b.st[0], nx = b.st[1];
        if (nloc == 0u) { xcd_barrier_complete(bar, b.x, nloc, nx); b.st[0] = nloc; b.st[1] = nx; }
        const unsigned old = xb_add(&bar[XB_XSUB(b.x)], 1u);
        const unsigned gen = old / nloc;
        if (old + 1u == (gen + 1u) * nloc) {
            __builtin_amdgcn_fence(__ATOMIC_RELEASE, "agent");
            asm volatile("s_waitcnt vmcnt(0)" ::: "memory");
            const unsigned og = xb_add(&bar[XB_TOP], 1u);
            const unsigned tg = og / nx;
            if (og + 1u == (tg + 1u) * nx) xb_add(&bar[XB_TOPGEN], 1u);
            else XB_SPIN(xb_ld(&bar[XB_TOPGEN]) == tg, bar);
            __builtin_amdgcn_fence(__ATOMIC_ACQUIRE, "agent");
            xb_add(&bar[XB_XGEN(b.x)], 1u);
            asm volatile("s_waitcnt vmcnt(0)" ::: "memory");
        } else {
            XB_SPIN(xb_ld(&bar[XB_XGEN(b.x)]) == gen, bar);
            __builtin_amdgcn_fence(__ATOMIC_ACQUIRE, "agent");
            asm volatile("s_waitcnt vmcnt(0)" ::: "memory");
        }
    }
    __syncthreads();
}

constexpr int DM = 2048, NBP = 4, SEQ = 8192, NBS = 32, DSEQ = 64, PAST = 2048;
constexpr int MP = NBP * SEQ, MS = NBS * DSEQ, M = MP + MS;
constexpr int AW = 1024, NH = 8, HD = 64, VD = 128, INW = 4096, DFF = 8192;
constexpr int SG = 64, SP = 64, SH = 16;
constexpr int TS = 16;
constexpr int NROW = M / TS, S5NT = 9, NROWP = S5NT * 256, S5K = 384;
constexpr int NMOD = 36, MODW = 6 * DM;
constexpr float RMS_EPS = 1e-6f;
constexpr float LAM_INIT = 0.2f;
constexpr size_t O_Y = 0, O_KP = (size_t)M * DM, O_VP = O_KP + (size_t)MP * AW, O_SRP = O_VP + (size_t)MP * AW, O_SIP = O_SRP + (size_t)NBP * SG * SP,
                 O_KS = O_SIP + (size_t)NBP * SG * SP, O_VS = O_KS + (size_t)MS * AW, O_SRS = O_VS + (size_t)MS * AW, O_SIS = O_SRS + (size_t)NBS * SG * SP, O_END = O_SIS + (size_t)NBS * SG * SP;
static_assert(O_END == 142901248, "output size");
enum { I_XP = 0, I_XS, I_CP, I_CS, I_CK, I_CV, I_SRE, I_SIM, I_WADA, I_BADA, I_GMIX, I_WIN, I_LQ1, I_LK1, I_LQ2, I_LK2, I_GSUB, I_LRE, I_LIM, I_LDT, I_BRE, I_BIM, I_CRE, I_CIM, I_SD, I_WGLU, I_BGLU, I_WOUT, I_GFFN, I_WFF1, I_WFF2, I_GFIN, N_IN };
static_assert(N_IN == 32, "inputs");

constexpr size_t MiB = 1u << 20;
constexpr size_t WS_CTL = 0, CTL_ZERO_BYTES = 1 * MiB;
constexpr size_t WS_A16 = 1 * MiB;
constexpr size_t WS_ROPE = 2 * MiB;
constexpr size_t WS_MOD = 3 * MiB;
constexpr size_t WS_WIN = 8 * MiB, WS_WGLU = 24 * MiB, WS_WOUT = 28 * MiB, WS_WFF1 = 36 * MiB, WS_WFF2 = 68 * MiB;
constexpr size_t WS_BTM = 100 * MiB;
constexpr size_t WS_BTE = 112 * MiB;
constexpr size_t WS_H = 120 * MiB;
constexpr size_t WS_E = WS_H, WS_Z = WS_H + 68 * MiB;
constexpr size_t WS_Q = 256 * MiB, WS_K = 324 * MiB, WS_V = 388 * MiB, WS_UR = 452 * MiB, WS_MIX = 560 * MiB;
constexpr size_t WS_HID = 256 * MiB, WS_END = 800 * MiB;
static_assert(WS_WIN + (size_t)INW * DM * 2 <= WS_WGLU && WS_WGLU + (size_t)2048 * 1024 * 2 <= WS_WOUT && WS_WOUT + (size_t)DM * DM * 2 <= WS_WFF1 && WS_WFF1 + (size_t)DFF * DM * 2 <= WS_WFF2 && WS_WFF2 + (size_t)DM * DFF * 2 <= WS_BTM, "ws map 1");
static_assert(WS_BTM + (size_t)SG * 256 * S5K * 2 <= WS_BTE && WS_BTE + (size_t)SG * 256 * 256 * 2 <= WS_H && WS_H + (size_t)M * DM * 2 <= WS_Q, "ws map 2");
static_assert((size_t)SG * NROW * 128 * 4 <= 68 * MiB && (size_t)M * AW * 2 <= 68 * MiB, "E|Z");
static_assert(WS_Q + (size_t)M * AW * 2 <= WS_K && WS_K + (size_t)MP * AW * 2 <= WS_V && WS_V + (size_t)MP * AW * 2 <= WS_UR && WS_UR + (size_t)SG * NROWP * S5K * 2 <= WS_MIX && WS_MIX + (size_t)M * DM * 2 <= WS_END, "ws map 3");
static_assert(WS_HID + (size_t)M * DFF * 2 <= WS_END && WS_MOD + (size_t)NMOD * MODW * 4 <= WS_WIN, "ws map 4");
constexpr int CW_BAR = 4096;

constexpr int RING_BYTES = 135168;
constexpr int LDSCTL_OFF = RING_BYTES, MISC_OFF = LDSCTL_OFF + 320;
constexpr int LDS_BYTES = 147456;
static_assert(MISC_OFF + 128 <= LDS_BYTES, "LDS map");
constexpr int NWAVES = 8;

namespace epi {
using pg8::f32x4; using pg8::u32x4; using pg8::Unit; using pg8::cvt_pk_bf16; using pg8::bf16_t;
typedef float (accT)[4];
__device__ __forceinline__ u32x4 pack8(const f32x4& a, const f32x4& b) { u32x4 w; w.x = cvt_pk_bf16(a[0], a[1]); w.y = cvt_pk_bf16(a[2], a[3]); w.z = cvt_pk_bf16(b[0], b[1]); w.w = cvt_pk_bf16(b[2], b[3]); return w; }
__device__ __forceinline__ int batch_of_tile(int pm, int ai, int wr) { return pm < 128 ? (pm >> 5) : 4 + (pm - 128) * 4 + 2 * ai + wr; }

struct EpiInProj {
    static constexpr bool PERM = true, AFTER_DRAIN = false;
    bf16_t* Q; bf16_t* Kb; bf16_t* Vb; bf16_t* Ur; float* out; const float* rope;
    __device__ __forceinline__ void operator()(const f32x4 (&acc)[2][2][4][2], const Unit& u, int wr, int wc, int fr, int fq) const {
        const int sect = u.pn >> 2, colt = (u.pn & 3) * 256 + wc * 32 + 8 * fq;
        const bool smp = u.pm >= 128;
        const int row0 = u.pm * 256 + wr * 64 + fr;
        if (sect <= 1) {
            const bool rot_wave = (wc & 1) == 0;
            float* okv = out + (smp ? O_KS : O_KP);
#pragma unroll
            for (int ai = 0; ai < 2; ++ai)
#pragma unroll
                for (int m = 0; m < 4; ++m) {
                    const int row = row0 + ai * 128 + m * 16;
                    const int pos = smp ? PAST + ((row - MP) & 63) : (row & (SEQ - 1));
                    f32x4 c0 = {1.f, 1.f, 1.f, 1.f}, c1 = c0, s0 = {0.f, 0.f, 0.f, 0.f}, s1 = s0;
                    if (rot_wave && fq < 2) { const f32x4* rp = (const f32x4*)(rope + (size_t)pos * 16); c0 = rp[0]; c1 = rp[1]; s0 = rp[2]; s1 = rp[3]; if (fq == 0) { s0 = -s0; s1 = -s1; } }
#pragma unroll
                    for (int bj = 0; bj < 2; ++bj) {
                        f32x4 v0 = acc[ai][bj][m][0], v1 = acc[ai][bj][m][1];
                        if (rot_wave) {
                            f32x4 p0, p1;
#pragma unroll
                            for (int j = 0; j < 4; ++j) { p0[j] = __shfl_xor(v0[j], 16); p1[j] = __shfl_xor(v1[j], 16); }
                            if (fq < 2) { v0 = v0 * c0 + p0 * s0; v1 = v1 * c1 + p1 * s1; }
                        }
                        const int col = colt + bj * 128;
                        if (sect == 0) { *(u32x4*)(Q + (size_t)row * AW + col) = pack8(v0, v1); }
                        else {
                            float* o = okv + (size_t)(smp ? row - MP : row) * AW + col; *(f32x4*)o = v0; *(f32x4*)(o + 4) = v1;
                            if (!smp) *(u32x4*)(Kb + (size_t)row * AW + col) = pack8(v0, v1);
                        }
                    }
                }
        } else if (sect == 2) {
            float* okv = out + (smp ? O_VS : O_VP);
#pragma unroll
            for (int ai = 0; ai < 2; ++ai)
#pragma unroll
                for (int m = 0; m < 4; ++m) {
                    const int row = row0 + ai * 128 + m * 16;
#pragma unroll
                    for (int bj = 0; bj < 2; ++bj) {
                        const f32x4 v0 = acc[ai][bj][m][0], v1 = acc[ai][bj][m][1]; const int col = colt + bj * 128;
                        float* o = okv + (size_t)(smp ? row - MP : row) * AW + col; *(f32x4*)o = v0; *(f32x4*)(o + 4) = v1;
                        if (!smp) *(u32x4*)(Vb + (size_t)row * AW + col) = pack8(v0, v1);
                    }
                }
        } else {
#pragma unroll
            for (int ai = 0; ai < 2; ++ai)
#pragma unroll
                for (int m = 0; m < 4; ++m) {
                    const int row = row0 + ai * 128 + m * 16;
#pragma unroll
                    for (int bj = 0; bj < 2; ++bj) {
                        const int col = colt + bj * 128, g = col >> 4, h0 = col & 15;
                        *(u32x4*)(Ur + ((size_t)g * NROWP + (row >> 4)) * S5K + (row & 15) * 16 + h0) = pack8(acc[ai][bj][m][0], acc[ai][bj][m][1]);
                    }
                }
        }
    }
};

struct EpiS5E {
    static constexpr bool PERM = true, AFTER_DRAIN = false;
    float* E;
    __device__ __forceinline__ void operator()(const f32x4 (&acc)[2][2][4][2], const Unit& u, int wr, int wc, int fr, int fq) const {
        const int g = u.pn, rt = u.pm - S5NT * g, row0 = rt * 256 + wr * 64 + fr, col = wc * 32 + 8 * fq;
#pragma unroll
        for (int ai = 0; ai < 2; ++ai)
#pragma unroll
            for (int m = 0; m < 4; ++m) { const int row = row0 + ai * 128 + m * 16;
                if (row < NROW) { float* o = E + ((size_t)g * NROW + row) * 128 + col; *(f32x4*)o = acc[ai][0][m][0]; *(f32x4*)(o + 4) = acc[ai][0][m][1]; } }
    }
};

__device__ __forceinline__ float gelu_tanh(float x) {
    const float y = x * (0.7978845608028654f + 0.035677408136300125f * x * x);
    const float e = __builtin_amdgcn_exp2f(y * 2.8853900817779268f);
    return x - x * __builtin_amdgcn_rcpf(e + 1.0f);
}
struct EpiS5Main {
    static constexpr bool PERM = true, AFTER_DRAIN = false;
    bf16_t* Z;
    __device__ __forceinline__ void operator()(const f32x4 (&acc)[2][2][4][2], const Unit& u, int wr, int wc, int fr, int fq) const {
        const int g = u.pn, rt = u.pm - S5NT * g, row0 = rt * 256 + wr * 64 + fr;
#pragma unroll
        for (int ai = 0; ai < 2; ++ai)
#pragma unroll
            for (int m = 0; m < 4; ++m) { const int row = row0 + ai * 128 + m * 16;
                if (row < NROW) {
#pragma unroll
                    for (int bj = 0; bj < 2; ++bj) { const int n0 = bj * 128 + wc * 32 + 8 * fq, t = n0 >> 4, h0 = n0 & 15;
                        f32x4 v0 = acc[ai][bj][m][0], v1 = acc[ai][bj][m][1];
#pragma unroll
                        for (int j = 0; j < 4; ++j) { v0[j] = gelu_tanh(v0[j]); v1[j] = gelu_tanh(v1[j]); }
                        *(u32x4*)(Z + (size_t)(row * TS + t) * AW + g * 16 + h0) = pack8(v0, v1); __builtin_amdgcn_sched_barrier(0); } } }
    }
};

struct EpiGlu {
    static constexpr bool PERM = true, AFTER_DRAIN = false;
    bf16_t* MIX; const float* bglu;
    __device__ __forceinline__ void operator()(const f32x4 (&acc)[2][2][4][2], const Unit& u, int wr, int wc, int fr, int fq) const {
        const int row0 = u.pm * 256 + wr * 64 + fr, col = u.pn * 128 + wc * 32 + 8 * fq;
        const f32x4 bv0 = *(const f32x4*)(bglu + col), bv1 = *(const f32x4*)(bglu + col + 4), bg0 = *(const f32x4*)(bglu + 1024 + col), bg1 = *(const f32x4*)(bglu + 1024 + col + 4);
#pragma unroll
        for (int ai = 0; ai < 2; ++ai)
#pragma unroll
            for (int m = 0; m < 4; ++m) { const int row = row0 + ai * 128 + m * 16;
                f32x4 v0 = acc[ai][0][m][0] + bv0, v1 = acc[ai][0][m][1] + bv1; const f32x4 g0 = acc[ai][1][m][0] + bg0, g1 = acc[ai][1][m][1] + bg1;
#pragma unroll
                for (int j = 0; j < 4; ++j) { v0[j] = v0[j] * __builtin_amdgcn_rcpf(1.0f + __builtin_amdgcn_exp2f(-1.4426950408889634f * g0[j])); v1[j] = v1[j] * __builtin_amdgcn_rcpf(1.0f + __builtin_amdgcn_exp2f(-1.4426950408889634f * g1[j])); }
                *(u32x4*)(MIX + (size_t)row * DM + 1024 + col) = pack8(v0, v1); __builtin_amdgcn_sched_barrier(0); }
    }
};

struct EpiOut {
    static constexpr bool PERM = true, AFTER_DRAIN = false;
    const float* xp; const float* xs; float* Y; const float* mod;
    __device__ __forceinline__ void operator()(const f32x4 (&acc)[2][2][4][2], const Unit& u, int wr, int wc, int fr, int fq) const {
        const int row0 = u.pm * 256 + wr * 64 + fr, col0 = u.pn * 256 + wc * 32 + 8 * fq;
        const float* xb = u.pm < 128 ? xp : xs - (size_t)MP * DM;
#pragma unroll
        for (int ai = 0; ai < 2; ++ai) {
            const float* gp = mod + (size_t)batch_of_tile(u.pm, ai, wr) * MODW + 2 * DM + col0;
            f32x4 gt[2][2];
#pragma unroll
            for (int bj = 0; bj < 2; ++bj) { gt[bj][0] = *(const f32x4*)(gp + bj * 128); gt[bj][1] = *(const f32x4*)(gp + bj * 128 + 4); }
#pragma unroll
            for (int m = 0; m < 4; ++m) { const size_t off = (size_t)(row0 + ai * 128 + m * 16) * DM + col0;
#pragma unroll
                for (int bj = 0; bj < 2; ++bj) { const f32x4 x0 = *(const f32x4*)(xb + off + bj * 128), x1 = *(const f32x4*)(xb + off + bj * 128 + 4);
                    *(f32x4*)(Y + off + bj * 128) = x0 + gt[bj][0] * acc[ai][bj][m][0]; *(f32x4*)(Y + off + bj * 128 + 4) = x1 + gt[bj][1] * acc[ai][bj][m][1]; }
                asm volatile("" ::: "memory"); }
        }
    }
};

struct EpiFF1 {
    static constexpr bool PERM = true, AFTER_DRAIN = false;
    bf16_t* HID;
    __device__ __forceinline__ void operator()(const f32x4 (&acc)[2][2][4][2], const Unit& u, int wr, int wc, int fr, int fq) const {
        const int row0 = u.pm * 256 + wr * 64 + fr, col0 = u.pn * 256 + wc * 32 + 8 * fq;
#pragma unroll
        for (int ai = 0; ai < 2; ++ai)
#pragma unroll
            for (int m = 0; m < 4; ++m) { bf16_t* rowp = HID + (size_t)(row0 + ai * 128 + m * 16) * DFF + col0;
#pragma unroll
                for (int bj = 0; bj < 2; ++bj) { f32x4 v0 = acc[ai][bj][m][0], v1 = acc[ai][bj][m][1];
#pragma unroll
                    for (int j = 0; j < 4; ++j) { const float a = fmaxf(v0[j], 0.f), b = fmaxf(v1[j], 0.f); v0[j] = a * a; v1[j] = b * b; }
                    *(u32x4*)(rowp + bj * 128) = pack8(v0, v1); } }
    }
};

struct EpiFF2 {
    static constexpr bool PERM = true, AFTER_DRAIN = false;
    float* Y; const float* mod;
    __device__ __forceinline__ void operator()(const f32x4 (&acc)[2][2][4][2], const Unit& u, int wr, int wc, int fr, int fq) const {
        const int row0 = u.pm * 256 + wr * 64 + fr, col0 = u.pn * 256 + wc * 32 + 8 * fq;
#pragma unroll
        for (int ai = 0; ai < 2; ++ai) {
            const float* gp = mod + (size_t)batch_of_tile(u.pm, ai, wr) * MODW + 5 * DM + col0;
            f32x4 gt[2][2];
#pragma unroll
            for (int bj = 0; bj < 2; ++bj) { gt[bj][0] = *(const f32x4*)(gp + bj * 128); gt[bj][1] = *(const f32x4*)(gp + bj * 128 + 4); }
#pragma unroll
            for (int m = 0; m < 4; ++m) { const size_t off = (size_t)(row0 + ai * 128 + m * 16) * DM + col0;
#pragma unroll
                for (int bj = 0; bj < 2; ++bj) { const f32x4 x0 = *(const f32x4*)(Y + off + bj * 128), x1 = *(const f32x4*)(Y + off + bj * 128 + 4);
                    *(f32x4*)(Y + off + bj * 128) = x0 + gt[bj][0] * acc[ai][bj][m][0]; *(f32x4*)(Y + off + bj * 128 + 4) = x1 + gt[bj][1] * acc[ai][bj][m][1]; }
                asm volatile("" ::: "memory"); }
        }
    }
};

struct S5Order {
    int G, c;
    __device__ __forceinline__ bool next(int i, Unit& u) const { const int L = i * G + c; if (L >= SG * S5NT) return false; const int g = L / S5NT; u.pm = L; u.pn = g; return true; }
    __device__ __forceinline__ void a_ready(const Unit&) const {}
    __device__ __forceinline__ void done(const Unit&) const {}
};
}

__device__ __forceinline__ float wave_sum(float v) {
#pragma unroll
    for (int o = 1; o < 64; o <<= 1) v += __shfl_xor(v, o);
    return v;
}
__device__ __forceinline__ double d_exp(double x) {
    const double k = __builtin_rint(x * 1.4426950408889634074);
    double r = __builtin_fma(-k, 6.93147180369123816490e-01, x); r = __builtin_fma(-k, 1.90821492927058770002e-10, r);
    double p = 1.0 / 6227020800.0;
    p = __builtin_fma(p, r, 1.0 / 479001600.0); p = __builtin_fma(p, r, 1.0 / 39916800.0); p = __builtin_fma(p, r, 1.0 / 3628800.0); p = __builtin_fma(p, r, 1.0 / 362880.0);
    p = __builtin_fma(p, r, 1.0 / 40320.0); p = __builtin_fma(p, r, 1.0 / 5040.0); p = __builtin_fma(p, r, 1.0 / 720.0); p = __builtin_fma(p, r, 1.0 / 120.0);
    p = __builtin_fma(p, r, 1.0 / 24.0); p = __builtin_fma(p, r, 1.0 / 6.0); p = __builtin_fma(p, r, 0.5); p = __builtin_fma(p, r, 1.0); p = __builtin_fma(p, r, 1.0);
    return ldexp(p, (int)k);
}
__device__ __forceinline__ void d_sincos(double x, double& s, double& c) {
    const double k = __builtin_rint(x * 0.63661977236758134308);
    double r = __builtin_fma(-k, 1.57079632673412561417e+00, x); r = __builtin_fma(-k, 6.07710050650619224932e-11, r);
    const double r2 = r * r;
    double ps = -1.0 / 1307674368000.0;
    ps = __builtin_fma(ps, r2, 1.0 / 6227020800.0); ps = __builtin_fma(ps, r2, -1.0 / 39916800.0); ps = __builtin_fma(ps, r2, 1.0 / 362880.0); ps = __builtin_fma(ps, r2, -1.0 / 5040.0);
    ps = __builtin_fma(ps, r2, 1.0 / 120.0); ps = __builtin_fma(ps, r2, -1.0 / 6.0); const double S = __builtin_fma(ps * r2, r, r);
    double pc = 1.0 / 20922789888000.0;
    pc = __builtin_fma(pc, r2, -1.0 / 87178291200.0); pc = __builtin_fma(pc, r2, 1.0 / 479001600.0); pc = __builtin_fma(pc, r2, -1.0 / 3628800.0); pc = __builtin_fma(pc, r2, 1.0 / 40320.0);
    pc = __builtin_fma(pc, r2, -1.0 / 720.0); pc = __builtin_fma(pc, r2, 1.0 / 24.0); pc = __builtin_fma(pc, r2, -0.5); const double C = __builtin_fma(pc, r2, 1.0);
    const int q = ((int)k) & 3;
    s = (q == 0) ? S : (q == 1) ? C : (q == 2) ? -S : -C;
    c = (q == 0) ? C : (q == 1) ? -S : (q == 2) ? -C : S;
}

struct Args { const float* in[32]; float* out; unsigned char* ws; };
typedef const __attribute__((address_space(4))) Args* KA;

__device__ __forceinline__ void p0_transpose_item(const float* W, int K, int N, bf16* WT, int wrow0, LAS float* scr, int k0, int n0, int lane) {
#pragma unroll 8
    for (int i = 0; i < 32; ++i) { const int kk = 2 * i + (lane >> 5); scr[kk * 33 + (lane & 31)] = W[(size_t)(k0 + kk) * N + n0 + (lane & 31)]; }
    LDS_WAIT(); asm volatile("" ::: "memory");
    const int c = lane & 7;
#pragma unroll
    for (int j = 0; j < 4; ++j) { const int n = (lane >> 3) + 8 * j; const LAS float* s = scr + (8 * c) * 33 + n;
        v4u o; o.x = pk2(s[0 * 33], s[1 * 33]); o.y = pk2(s[2 * 33], s[3 * 33]); o.z = pk2(s[4 * 33], s[5 * 33]); o.w = pk2(s[6 * 33], s[7 * 33]);
        *(GAS v4u*)(WT + (size_t)(wrow0 + n) * K + k0 + 8 * c) = o; }
    LDS_WAIT(); asm volatile("" ::: "memory");
}

__device__ __forceinline__ void ada_item(KA a, int it, LAS unsigned char* lds, int tid, int wave, int lane, float* MOD) {
    LAS float* S = (LAS float*)lds;
    const float* wada = a->in[I_WADA]; const float* bada = a->in[I_BADA]; const float* cp = a->in[I_CP]; const float* cs = a->in[I_CS];
    const int n0 = it * 64;
    float acc[36];
#pragma unroll
    for (int i = 0; i < 36; ++i) acc[i] = 0.f;
    for (int q = 0; q < 4; ++q) {
        __syncthreads();
#pragma unroll 4
        for (int bb = 0; bb < 36; ++bb) { const float c = bb < 4 ? cp[bb * DM + q * 512 + tid] : cs[(bb - 4) * DM + q * 512 + tid]; S[tid * 36 + bb] = c / (1.0f + __expf(-c)); }
        __syncthreads();
        const float* wp = wada + (size_t)(q * 512 + wave * 64) * MODW + n0 + lane;
#pragma unroll 4
        for (int kk = 0; kk < 64; ++kk) {
            const float wv = wp[(size_t)kk * MODW]; const LAS f32x4* sp = (const LAS f32x4*)(S + (wave * 64 + kk) * 36);
#pragma unroll
            for (int q4 = 0; q4 < 9; ++q4) { const f32x4 s4 = sp[q4]; acc[4 * q4 + 0] += s4.x * wv; acc[4 * q4 + 1] += s4.y * wv; acc[4 * q4 + 2] += s4.z * wv; acc[4 * q4 + 3] += s4.w * wv; }
        }
    }
    __syncthreads();
    LAS float* R = (LAS float*)lds;
#pragma unroll
    for (int bb = 0; bb < 36; ++bb) R[(wave * 36 + bb) * 64 + lane] = acc[bb];
    __syncthreads();
    for (int o = tid; o < 36 * 64; o += 512) { const int bb = o >> 6, ln = o & 63; float s = bada[n0 + ln];
#pragma unroll
        for (int w = 0; w < 8; ++w) s += R[(w * 36 + bb) * 64 + ln];
        MOD[(size_t)bb * MODW + n0 + ln] = s; }
    __syncthreads();
}

__device__ __forceinline__ void s5_gen_group(KA a, int g, LAS unsigned char* lds, int tid, bf16* BTM, bf16* BTE, float* A16) {
    LAS float* APOW = (LAS float*)lds;
    LAS float* BB = APOW + 17 * 64 * 2;
    LAS float* CC = BB + 64 * 16 * 2;
    LAS float* KM = CC + 16 * 64 * 2;
    __syncthreads();
    if (tid < 64) {
        const int p = tid;
        const double dt = d_exp((double)a->in[I_LDT][g]);
        const double lre = (double)a->in[I_LRE][g * SP + p], lim = (double)a->in[I_LIM][g * SP + p];
        double a1r = 1.0, a1i = 0.0;
        for (int m = 0; m <= 16; ++m) {
            const double mag = d_exp(lre * dt * (double)m); double sn, cs; d_sincos(lim * dt * (double)m, sn, cs);
            const double ar = mag * cs, ai = mag * sn;
            APOW[(m * 64 + p) * 2 + 0] = (float)ar; APOW[(m * 64 + p) * 2 + 1] = (float)ai;
            if (m == 1) { a1r = ar; a1i = ai; }
            if (m == 16) { A16[(g * SP + p) * 2 + 0] = (float)ar; A16[(g * SP + p) * 2 + 1] = (float)ai; }
        }
        const double den = lre * lre + lim * lim;
        const double fre = ((a1r - 1.0) * lre + a1i * lim) / den, fim = (a1i * lre - (a1r - 1.0) * lim) / den;
        for (int h = 0; h < SH; ++h) {
            const double br = (double)a->in[I_BRE][(g * SP + p) * SH + h], bi = (double)a->in[I_BIM][(g * SP + p) * SH + h];
            BB[(p * 16 + h) * 2 + 0] = (float)(fre * br - fim * bi); BB[(p * 16 + h) * 2 + 1] = (float)(fre * bi + fim * br);
        }
    }
    for (int e = tid; e < SH * SP; e += 512) { CC[e * 2 + 0] = a->in[I_CRE][g * SH * SP + e]; CC[e * 2 + 1] = a->in[I_CIM][g * SH * SP + e]; }
    __syncthreads();
    for (int e = tid; e < 16 * 16 * 16; e += 512) {
        const int m = e >> 8, h = (e >> 4) & 15, h2 = e & 15; float s = 0.f;
        for (int p = 0; p < SP; ++p) {
            const float cr = CC[(h * 64 + p) * 2], ci = CC[(h * 64 + p) * 2 + 1], ar = APOW[(m * 64 + p) * 2], ai = APOW[(m * 64 + p) * 2 + 1];
            const float wr = cr * ar - ci * ai, wi = cr * ai + ci * ar;
            s += wr * BB[(p * 16 + h2) * 2] - wi * BB[(p * 16 + h2) * 2 + 1];
        }
        if (m == 0 && h == h2) s += a->in[I_SD][g * SH + h];
        KM[e] = s;
    }
    __syncthreads();
    for (int q = tid; q < 256 * 48; q += 512) {
        const int n = q / 48, kp = q - n * 48, t = n >> 4, h = n & 15; float v[8];
        if (kp < 32) { const int j = kp >> 1, h0 = (kp & 1) * 8;
#pragma unroll
            for (int x = 0; x < 8; ++x) v[x] = (t >= j) ? KM[((t - j) * 16 + h) * 16 + h0 + x] : 0.f;
        } else { const int kk0 = (kp - 32) * 8, p0 = kk0 & 63, im = kk0 >> 6;
#pragma unroll
            for (int x = 0; x < 8; ++x) { const int p = p0 + x; const float cr = CC[(h * 64 + p) * 2], ci = CC[(h * 64 + p) * 2 + 1], ar = APOW[((t + 1) * 64 + p) * 2], ai = APOW[((t + 1) * 64 + p) * 2 + 1];
                v[x] = im ? (-cr * ai - ci * ar) : (cr * ar - ci * ai); }
        }
        v4u o; o.x = pk2(v[0], v[1]); o.y = pk2(v[2], v[3]); o.z = pk2(v[4], v[5]); o.w = pk2(v[6], v[7]);
        *(GAS v4u*)(BTM + ((size_t)g * 256 + n) * S5K + 8 * kp) = o;
    }
    for (int q = tid; q < 128 * 32; q += 512) {
        const int n = q >> 5, kp = q & 31, j = kp >> 1, h0 = (kp & 1) * 8, p = n & 63, im = n >> 6; float v[8];
        const float ar = APOW[((15 - j) * 64 + p) * 2], ai = APOW[((15 - j) * 64 + p) * 2 + 1];
#pragma unroll
        for (int x = 0; x < 8; ++x) { const float br = BB[(p * 16 + h0 + x) * 2], bi = BB[(p * 16 + h0 + x) * 2 + 1]; v[x] = im ? (ar * bi + ai * br) : (ar * br - ai * bi); }
        v4u o; o.x = pk2(v[0], v[1]); o.y = pk2(v[2], v[3]); o.z = pk2(v[4], v[5]); o.w = pk2(v[6], v[7]);
        *(GAS v4u*)(BTE + ((size_t)g * 256 + n) * 256 + 8 * kp) = o;
    }
    __syncthreads();
}

__device__ __forceinline__ int batch_of_row(int r) { return r < MP ? (r >> 13) : 4 + ((r - MP) >> 6); }
template <int WHICH> __device__ __forceinline__ void norm_mod_pass(KA a, const float* MOD, const float* Y, bf16* H, int gw, int ngw, int lane) {
    const int per = (M + ngw - 1) / ngw, r0 = gw * per, r1 = (r0 + per < M) ? r0 + per : M;
    const float* gvec = a->in[WHICH == 0 ? I_GMIX : I_GFFN];
    const int sh_chunk = WHICH == 0 ? 0 : 3, sc_chunk = WHICH == 0 ? 1 : 4;
    int cur_b = -1; f32x4 gs[8], sh[8];
#pragma unroll
    for (int j = 0; j < 8; ++j) { gs[j] = (f32x4){0.f, 0.f, 0.f, 0.f}; sh[j] = gs[j]; }
    for (int r = r0; r < r1; ++r) {
        const int b = batch_of_row(r);
        if (b != cur_b) { cur_b = b; const float* mp = MOD + (size_t)b * MODW;
#pragma unroll
            for (int j = 0; j < 8; ++j) { const int k = 4 * lane + 256 * j; const f32x4 g4 = *(const f32x4*)(gvec + k), s4 = *(const f32x4*)(mp + sc_chunk * DM + k); gs[j] = g4 * (s4 + 1.0f); sh[j] = *(const f32x4*)(mp + sh_chunk * DM + k); } }
        const float* src = WHICH == 0 ? (r < MP ? a->in[I_XP] + (size_t)r * DM : a->in[I_XS] + (size_t)(r - MP) * DM) : Y + (size_t)r * DM;
        f32x4 v[8]; float ss = 0.f;
#pragma unroll
        for (int j = 0; j < 8; ++j) { v[j] = *(const f32x4*)(src + 4 * lane + 256 * j); ss += (v[j].x * v[j].x + v[j].y * v[j].y) + (v[j].z * v[j].z + v[j].w * v[j].w); }
        const float rstd = 1.0f / sqrtf(wave_sum(ss) * (1.0f / DM) + RMS_EPS);
        bf16* dst = H + (size_t)r * DM + 4 * lane;
#pragma unroll
        for (int j = 0; j < 8; ++j) { const f32x4 h = v[j] * rstd * gs[j] + sh[j];
            *(GAS unsigned long long*)(dst + 256 * j) = (unsigned long long)pk2(h.x, h.y) | ((unsigned long long)pk2(h.z, h.w) << 32); }
    }
}
__device__ __forceinline__ void final_norm_pass(KA a, float* Y, int gw, int ngw, int lane) {
    const float* gvec = a->in[I_GFIN]; f32x4 g4[8];
#pragma unroll
    for (int j = 0; j < 8; ++j) g4[j] = *(const f32x4*)(gvec + 4 * lane + 256 * j);
    for (int r = gw; r < M; r += ngw) {
        float* row = Y + (size_t)r * DM + 4 * lane; f32x4 v[8]; float ss = 0.f;
#pragma unroll
        for (int j = 0; j < 8; ++j) { v[j] = *(const f32x4*)(row + 256 * j); ss += (v[j].x * v[j].x + v[j].y * v[j].y) + (v[j].z * v[j].z + v[j].w * v[j].w); }
        const float rstd = 1.0f / sqrtf(wave_sum(ss) * (1.0f / DM) + RMS_EPS);
#pragma unroll
        for (int j = 0; j < 8; ++j) *(f32x4*)(row + 256 * j) = v[j] * rstd * g4[j];
    }
}

template <int NSTEP, bool STORE> __device__ __forceinline__ void carry_steps(const float* __restrict__ Eg, bf16* __restrict__ Ug, int row0, int p, float a16r, float a16i, float& hr, float& hi) {
    float er[NSTEP], ei[NSTEP];
#pragma unroll
    for (int k = 0; k < NSTEP; ++k) { er[k] = Eg[(size_t)(row0 + k) * 128 + p]; ei[k] = Eg[(size_t)(row0 + k) * 128 + 64 + p]; }
#pragma unroll
    for (int k = 0; k < NSTEP; ++k) {
        if (STORE) { bf16* u = Ug + (size_t)(row0 + k) * S5K + 256 + p; u[0] = (bf16)f2bf(hr); u[64] = (bf16)f2bf(hi); }
        const float nr = a16r * hr - a16i * hi + er[k], ni = a16r * hi + a16i * hr + ei[k]; hr = nr; hi = ni;
    }
}
__device__ __forceinline__ void carry_scan(KA a, const float* E, bf16* Ur, const float* A16, float* out, LAS unsigned char* lds, int vcu, int G, int wave, int lane) {
    const int p = lane;
    for (int s = vcu * NWAVES + wave; s < NBS * SG; s += G * NWAVES) {
        const int bs = s >> 6, g = s & 63; const float a16r = A16[(g * SP + p) * 2], a16i = A16[(g * SP + p) * 2 + 1];
        float hr = a->in[I_SRE][(bs * SG + g) * SP + p], hi = a->in[I_SIM][(bs * SG + g) * SP + p];
        carry_steps<4, true>(E + (size_t)g * NROW * 128, Ur + (size_t)g * NROWP * S5K, MP / TS + bs * 4, p, a16r, a16i, hr, hi);
        out[O_SRS + (bs * SG + g) * SP + p] = hr; out[O_SIS + (bs * SG + g) * SP + p] = hi;
    }
    LAS float* SEGL = (LAS float*)lds;
    for (int l = vcu; l < NBP * SG; l += G) {
        const int b = l >> 6, g = l & 63, seg = wave; const float a16r = A16[(g * SP + p) * 2], a16i = A16[(g * SP + p) * 2 + 1];
        const float* Eg = E + (size_t)g * NROW * 128; bf16* Ug = Ur + (size_t)g * NROWP * S5K; const int row0 = b * (SEQ / TS) + seg * 64;
        float hr = 0.f, hi = 0.f;
#pragma unroll 1
        for (int k0 = 0; k0 < 64; k0 += 16) carry_steps<16, false>(Eg, Ug, row0 + k0, p, a16r, a16i, hr, hi);
        __syncthreads();
        SEGL[(seg * 64 + p) * 2] = hr; SEGL[(seg * 64 + p) * 2 + 1] = hi;
        __syncthreads();
        float pr = a16r, pi = a16i;
#pragma unroll
        for (int q = 0; q < 6; ++q) { const float nr = pr * pr - pi * pi, ni = 2.f * pr * pi; pr = nr; pi = ni; }
        hr = 0.f; hi = 0.f;
        for (int s2 = 0; s2 < seg; ++s2) { const float lr = SEGL[(s2 * 64 + p) * 2], li = SEGL[(s2 * 64 + p) * 2 + 1]; const float nr = pr * hr - pi * hi + lr, ni = pr * hi + pi * hr + li; hr = nr; hi = ni; }
#pragma unroll 1
        for (int k0 = 0; k0 < 64; k0 += 16) carry_steps<16, true>(Eg, Ug, row0 + k0, p, a16r, a16i, hr, hi);
        if (seg == 7) { out[O_SRP + (b * SG + g) * SP + p] = hr; out[O_SIP + (b * SG + g) * SP + p] = hi; }
    }
}

namespace att {
using bf16x8 = __attribute__((ext_vector_type(8))) short;
using s16x4  = __attribute__((ext_vector_type(4))) short;
using f32x16 = __attribute__((ext_vector_type(16))) float;
using f32x8  = __attribute__((ext_vector_type(8))) float;
using u32x4  = __attribute__((ext_vector_type(4))) unsigned;
constexpr int QBLK = 32, KVBLK = 64, LDKV = 1024;
constexpr float SCALE = 0.125f, THR = 8.f;
constexpr int SHM_V = KVBLK * 128 * 2, SHM_K = KVBLK * 128 * 2;
constexpr int OFF_V = 0, OFF_K = 2 * SHM_V, OFF_WS = OFF_K + 2 * SHM_K, OFF_XCH = OFF_WS + NWAVES * 64 * 4, ATT_LDS = OFF_XCH + 4 * 16384;
static_assert(ATT_LDS <= RING_BYTES, "attention LDS");
#define KSWZ(row, colB) ((row) * 256 + ((colB) ^ (((row) & 7) << 4)))
#define SBAR() __builtin_amdgcn_sched_barrier(0)
__device__ __forceinline__ int crow(int r, int hi) { return (r & 3) + 8 * (r >> 2) + 4 * hi; }
__device__ __forceinline__ unsigned cvtpk(float lo, float hi) { unsigned r; asm volatile("v_cvt_pk_bf16_f32 %0, %1, %2" : "=v"(r) : "v"(lo), "v"(hi)); return r; }
template <typename TIn> struct Stage;
template <> struct Stage<bf16>  { using T = bf16x8;
  __device__ static __forceinline__ T ld8(const bf16* p) { return *reinterpret_cast<const bf16x8*>(p); }
  __device__ static __forceinline__ bf16x8 tobf(T x) { return x; } };
template <> struct Stage<float> { using T = f32x8;
  __device__ static __forceinline__ T ld8(const float* p) { return *reinterpret_cast<const f32x8*>(p); }
  __device__ static __forceinline__ bf16x8 tobf(T x) {
    u32x4 w = {cvtpk(x[0], x[1]), cvtpk(x[2], x[3]), cvtpk(x[4], x[5]), cvtpk(x[6], x[7])}; return *reinterpret_cast<bf16x8*>(&w); } };

__device__ __forceinline__ void partialSM(f32x16& p0, f32x16& p1, float& m_reg, float& mn, float& alpha) {
  constexpr float C = SCALE * 1.4426950408889634f;
  float pmax = p0[0];
#pragma unroll
  for (int r = 1; r < 16; ++r) pmax = fmaxf(pmax, p0[r]);
#pragma unroll
  for (int r = 0; r < 16; ++r) pmax = fmaxf(pmax, p1[r]);
  { auto rr = __builtin_amdgcn_permlane32_swap(__float_as_uint(pmax), __float_as_uint(pmax), false, false);
    pmax = fmaxf(__uint_as_float(rr[0]), __uint_as_float(rr[1])); }
  if (__builtin_expect(__all(pmax - m_reg <= THR / SCALE), 1)) { mn = m_reg; alpha = 1.f; }
  else { mn = fmaxf(m_reg, pmax); alpha = __builtin_amdgcn_exp2f((m_reg - mn) * C); m_reg = mn; }
  float mnC = -mn * C;
#pragma unroll
  for (int r = 0; r < 16; ++r) p0[r] = fmaf(p0[r], C, mnC);
#pragma unroll
  for (int r = 0; r < 16; ++r) p1[r] = fmaf(p1[r], C, mnC);
#pragma unroll
  for (int r = 0; r < 16; ++r) p0[r] = __builtin_amdgcn_exp2f(p0[r]);
}
__device__ __forceinline__ void finishSM(f32x16& p0, f32x16& p1, float alpha, float& l_reg, bf16x8& pa0, bf16x8& pa1, bf16x8& pa2, bf16x8& pa3) {
#pragma unroll
  for (int r = 0; r < 16; ++r) p1[r] = __builtin_amdgcn_exp2f(p1[r]);
  float ps = 0;
#pragma unroll
  for (int r = 0; r < 16; ++r) ps += p0[r];
#pragma unroll
  for (int r = 0; r < 16; ++r) ps += p1[r];
  { auto rr = __builtin_amdgcn_permlane32_swap(__float_as_uint(ps), __float_as_uint(ps), false, false);
    ps = __uint_as_float(rr[0]) + __uint_as_float(rr[1]); }
  l_reg = l_reg * alpha + ps;
#define PK4(P, BASE, OUT) do { unsigned a0 = cvtpk(P[BASE + 0], P[BASE + 1]), a1 = cvtpk(P[BASE + 2], P[BASE + 3]);   \
    unsigned b0 = cvtpk(P[BASE + 4], P[BASE + 5]), b1 = cvtpk(P[BASE + 6], P[BASE + 7]);                              \
    auto r0 = __builtin_amdgcn_permlane32_swap(a0, b0, false, false); auto r1 = __builtin_amdgcn_permlane32_swap(a1, b1, false, false); \
    u32x4 w = {r0[0], r1[0], r0[1], r1[1]}; OUT = *reinterpret_cast<bf16x8*>(&w); } while (0)
  PK4(p0, 0, pa0); PK4(p0, 8, pa1); PK4(p1, 0, pa2); PK4(p1, 8, pa3);
#undef PK4
}
__device__ __forceinline__ void qkt(f32x16& p0, f32x16& p1, const char* Ks  , const bf16x8* qr, int r32, int hi) {
  p0 = f32x16{}; p1 = f32x16{};
#pragma unroll
  for (int d0 = 0; d0 < 4; ++d0) { const int cb = (d0 * 16 + hi * 8) * 2;
    bf16x8 b0 = *reinterpret_cast<const bf16x8*>(Ks + KSWZ(r32, cb));
    bf16x8 b1 = *reinterpret_cast<const bf16x8*>(Ks + KSWZ(32 + r32, cb));
    p0 = __builtin_amdgcn_mfma_f32_32x32x16_bf16(b0, qr[d0], p0, 0, 0, 0);
    p1 = __builtin_amdgcn_mfma_f32_32x32x16_bf16(b1, qr[d0], p1, 0, 0, 0); }
}
__device__ __forceinline__ int v_st(int k, int c) { const int kk = (k & ~0xC) | ((k & 4) << 1) | ((k & 8) >> 1); return ((kk >> 3) * 4 + (c >> 5)) * 512 + ((kk & 7) * 32 + (c & 31)) * 2; }
__device__ __forceinline__ int v_rd_base(int lane) { return ((lane & 3) << 3) | (((lane >> 2) & 3) << 6) | (((lane >> 4) & 1) << 5) | (((lane >> 5) & 1) << 8); }
constexpr int v_rd_off(int d0, int ks, int half) { return d0 * 512 + ks * 4096 + half * 2048; }
template <int OFF> __device__ __forceinline__ s16x4 tr_read(int vb) {
  s16x4 r; asm volatile("ds_read_b64_tr_b16 %0, %1 offset:%2" : "=&v"(r) : "v"(vb), "i"(OFF) : "memory"); return r;
}
template <int D0> __device__ __forceinline__ void pv_one(f32x16& od, int vb, bf16x8 pa0, bf16x8 pa1, bf16x8 pa2, bf16x8 pa3) {
  const s16x4 l0 = tr_read<v_rd_off(D0, 0, 0)>(vb), h0 = tr_read<v_rd_off(D0, 0, 1)>(vb), l1 = tr_read<v_rd_off(D0, 1, 0)>(vb), h1 = tr_read<v_rd_off(D0, 1, 1)>(vb);
  const s16x4 l2 = tr_read<v_rd_off(D0, 2, 0)>(vb), h2 = tr_read<v_rd_off(D0, 2, 1)>(vb), l3 = tr_read<v_rd_off(D0, 3, 0)>(vb), h3 = tr_read<v_rd_off(D0, 3, 1)>(vb);
  asm volatile("s_waitcnt lgkmcnt(0)" ::: "memory"); SBAR();
#define PK(L, H) (bf16x8){L[0], L[1], L[2], L[3], H[0], H[1], H[2], H[3]}
  od = __builtin_amdgcn_mfma_f32_32x32x16_bf16(pa0, PK(l0, h0), od, 0, 0, 0);
  od = __builtin_amdgcn_mfma_f32_32x32x16_bf16(pa1, PK(l1, h1), od, 0, 0, 0);
  od = __builtin_amdgcn_mfma_f32_32x32x16_bf16(pa2, PK(l2, h2), od, 0, 0, 0);
  od = __builtin_amdgcn_mfma_f32_32x32x16_bf16(pa3, PK(l3, h3), od, 0, 0, 0);
#undef PK
}
__device__ __forceinline__ void pv_d0(f32x16* o, int vb, bf16x8 pa0, bf16x8 pa1, bf16x8 pa2, bf16x8 pa3) {
  pv_one<0>(o[0], vb, pa0, pa1, pa2, pa3); pv_one<1>(o[1], vb, pa0, pa1, pa2, pa3); pv_one<2>(o[2], vb, pa0, pa1, pa2, pa3); pv_one<3>(o[3], vb, pa0, pa1, pa2, pa3);
}

template <typename TKV, int SDEPTH>
__device__ __forceinline__ void attn_unit(const bf16* Qw, const TKV* Kh, const TKV* Vh, const TKV* Kn, const TKV* Vn, int ncache, int NT,
                                          bool active, int c, int rb, int limit, float lam, const float* gsub, bf16* Ow, char* lds) {
  using St = Stage<TKV>;
  int tid = threadIdx.x; asm volatile("" : "+v"(tid));
  const int wid = __builtin_amdgcn_readfirstlane(tid >> 6), lane = tid & 63, r32 = lane & 31, hi = lane >> 5;
  char* V_lds = lds + OFF_V; char* K_lds = lds + OFF_K; const char* K_c = K_lds + c * 128;
  float* ws = (float*)(lds + OFF_WS) + wid * 64; float* li_l = ws; float* al_l = ws + 32;
  float m_reg = -1e30f, l_reg = 0; f32x16 o[4] = {}; bf16x8 qr[4];
  if (active) {
    const bf16* Ql = Qw + (long)r32 * LDKV + hi * 8;
#pragma unroll
    for (int d0 = 0; d0 < 4; ++d0) qr[d0] = *reinterpret_cast<const bf16x8*>(Ql + d0 * 16);
  } else {
#pragma unroll
    for (int d0 = 0; d0 < 4; ++d0) qr[d0] = bf16x8{};
  }
  const int sr = tid >> 4, sc = (tid & 15) * 8, vst0 = v_st(sr, sc), vst1 = v_st(32 + sr, sc);
  const int vb0 = (int)(uintptr_t)V_lds + v_rd_base(lane);
  struct { typename St::T vs0, vs1, ks0, ks1; } sr_[SDEPTH];
  unsigned goff0 = (unsigned)((sr * LDKV + sc) * sizeof(TKV)), goff1 = (unsigned)(((32 + sr) * LDKV + sc) * sizeof(TKV));
  asm volatile("" : "+v"(goff0), "+v"(goff1));
#define SLOAD(i, t) do { const int t_ = (t); const char* kp_ = (const char*)(t_ < ncache ? Kh + (long)t_ * KVBLK * LDKV : Kn); const char* vp_ = (const char*)(t_ < ncache ? Vh + (long)t_ * KVBLK * LDKV : Vn); \
    sr_[i].vs0 = *reinterpret_cast<const typename St::T*>(vp_ + goff0); sr_[i].vs1 = *reinterpret_cast<const typename St::T*>(vp_ + goff1); \
    sr_[i].ks0 = *reinterpret_cast<const typename St::T*>(kp_ + goff0); sr_[i].ks1 = *reinterpret_cast<const typename St::T*>(kp_ + goff1); } while (0)
#define SWRITE(b, i) do { *(bf16x8*)(V_lds + (b) * SHM_V + vst0) = St::tobf(sr_[i].vs0);          \
    *(bf16x8*)(V_lds + (b) * SHM_V + vst1) = St::tobf(sr_[i].vs1); int kc = sc * 2;               \
    *(bf16x8*)(K_lds + (b) * SHM_K + KSWZ(sr, kc)) = St::tobf(sr_[i].ks0);                       \
    *(bf16x8*)(K_lds + (b) * SHM_K + KSWZ(32 + sr, kc)) = St::tobf(sr_[i].ks1); } while (0)
#define SWAIT() do { if constexpr (SDEPTH == 2) asm volatile("s_waitcnt vmcnt(4)" ::: "memory"); else asm volatile("s_waitcnt vmcnt(0)" ::: "memory"); } while (0)
#define RESC(a) do { if (__any((a) < 1.f)) { if (hi == 0) al_l[r32] = (a); asm volatile("s_waitcnt lgkmcnt(0)" ::: "memory"); \
    _Pragma("unroll") for (int d = 0; d < 4; ++d) _Pragma("unroll") for (int r = 0; r < 16; ++r) o[d][r] *= al_l[crow(r, hi)]; } } while (0)
#define MASKT(P0, P1, t) do { if ((t) >= limit) { _Pragma("unroll") for (int r = 0; r < 16; ++r) { P0[r] = -1e30f; P1[r] = -1e30f; } } } while (0)
  f32x16 pA0 = {}, pA1 = {}, pB0 = {}, pB1 = {}; float mnA = 0.f, mnB = 0.f, alA = 1.f, alB = 1.f; bf16x8 pa0 = {}, pa1 = {}, pa2 = {}, pa3 = {};
  constexpr int SE = 0, SO = SDEPTH - 1;
  SLOAD(SE, 0); asm volatile("s_waitcnt vmcnt(0)" ::: "memory"); SWRITE(0, SE); __syncthreads();
  if (active) { qkt(pA0, pA1, K_c, qr, r32, hi); MASKT(pA0, pA1, 0); partialSM(pA0, pA1, m_reg, mnA, alA); }
  SLOAD(SO, 1); if constexpr (SDEPTH == 2) { if (2 < NT) SLOAD(SE, 2); }
  SWAIT(); SWRITE(1, SO); __syncthreads();
  for (int j = 1; j + 1 < NT; j += 2) {
    if (active) { SBAR(); qkt(pB0, pB1, K_c + SHM_K, qr, r32, hi); MASKT(pB0, pB1, j);
      finishSM(pA0, pA1, alA, l_reg, pa0, pa1, pa2, pa3); SBAR(); }
    SLOAD(SO, j + SDEPTH); SBAR();
    if (active) { pv_d0(o, vb0, pa0, pa1, pa2, pa3); partialSM(pB0, pB1, m_reg, mnB, alB); }
    __syncthreads(); SWAIT(); SWRITE(0, SE);
    if (active) { RESC(alB); }
    __syncthreads();
    if (active) { SBAR(); qkt(pA0, pA1, K_c, qr, r32, hi); MASKT(pA0, pA1, j + 1);
      finishSM(pB0, pB1, alB, l_reg, pa0, pa1, pa2, pa3); SBAR(); }
    if (SDEPTH == 1 || j + 3 < NT) SLOAD(SE, j + 1 + SDEPTH); SBAR();
    if (active) { pv_d0(o, vb0 + (int)SHM_V, pa0, pa1, pa2, pa3); partialSM(pA0, pA1, m_reg, mnA, alA); }
    __syncthreads(); SWAIT(); SWRITE(1, SO);
    if (active) { RESC(alA); }
    __syncthreads();
  }
  if (active) { SBAR(); qkt(pB0, pB1, K_c + SHM_K, qr, r32, hi); MASKT(pB0, pB1, NT - 1);
    finishSM(pA0, pA1, alA, l_reg, pa0, pa1, pa2, pa3); SBAR();
    pv_d0(o, vb0, pa0, pa1, pa2, pa3); partialSM(pB0, pB1, m_reg, mnB, alB); }
  __syncthreads();
  if (active) { RESC(alB);
    finishSM(pB0, pB1, alB, l_reg, pa0, pa1, pa2, pa3); SBAR();
    pv_d0(o, vb0 + (int)SHM_V, pa0, pa1, pa2, pa3); }
  float rli[16];
  if (active) {
    if (hi == 0) li_l[r32] = l_reg; asm volatile("s_waitcnt lgkmcnt(0)" ::: "memory");
#pragma unroll
    for (int r = 0; r < 16; ++r) rli[r] = __builtin_amdgcn_rcpf(li_l[crow(r, hi)]);
    if (c == 1) { float* x = (float*)(lds + OFF_XCH) + rb * 4096 + lane;
#pragma unroll
      for (int d0 = 0; d0 < 4; ++d0)
#pragma unroll
        for (int r = 0; r < 16; ++r) x[(d0 * 16 + r) * 64] = o[d0][r] * rli[r]; }
  }
  __syncthreads();
  if (active && c == 0) {
    const float* x = (const float*)(lds + OFF_XCH) + rb * 4096 + lane; float ss[16];
#pragma unroll
    for (int r = 0; r < 16; ++r) ss[r] = 0.f;
#pragma unroll
    for (int d0 = 0; d0 < 4; ++d0)
#pragma unroll
      for (int r = 0; r < 16; ++r) { const float v = o[d0][r] * rli[r] - lam * x[(d0 * 16 + r) * 64]; o[d0][r] = v; ss[r] += v * v; }
#pragma unroll
    for (int r = 0; r < 16; ++r) {
#pragma unroll
      for (int s = 1; s < 32; s <<= 1) ss[r] += __shfl_xor(ss[r], s);
      ss[r] = (1.0f - LAM_INIT) / sqrtf(ss[r] * (1.0f / VD) + RMS_EPS); }
    float gl[4];
#pragma unroll
    for (int d0 = 0; d0 < 4; ++d0) gl[d0] = gsub[d0 * 32 + r32];
#pragma unroll
    for (int r = 0; r < 16; ++r) { bf16* orow = Ow + (long)crow(r, hi) * DM + r32;
#pragma unroll
      for (int d0 = 0; d0 < 4; ++d0) orow[d0 * 32] = (bf16)f2bf(o[d0][r] * ss[r] * gl[d0]); }
  }
#undef SLOAD
#undef SWRITE
#undef SWAIT
#undef RESC
#undef MASKT
}
#undef SBAR
#undef KSWZ
}

constexpr int TI_IN = (DM / 64) * (INW / 32), TI_GLU = (1024 / 64) * (2048 / 32), TI_OUT = (DM / 64) * (DM / 32), TI_FF1 = (DM / 64) * (DFF / 32), TI_FF2 = (DFF / 64) * (DM / 32);
constexpr int TI_ALL = TI_IN + TI_GLU + TI_OUT + TI_FF1 + TI_FF2;

template <class T> __device__ __forceinline__ T* launder_s(T* p) { asm volatile("" : "+s"(p)); return p; }
#define PHASE_LOCALS() int tid = threadIdx.x; asm volatile("" : "+v"(tid)); const int lane = tid & 63, wave = __builtin_amdgcn_readfirstlane(tid >> 6), gw = vcu * NWAVES + wave, NGW = G * NWAVES; \
    KA ka = (KA)__builtin_amdgcn_kernarg_segment_ptr(); asm volatile("" : "+s"(ka)); unsigned char* ws = ka->ws; float* out = ka->out; (void)ka; (void)lane; (void)gw; (void)NGW; (void)ws; (void)out
__global__ void __launch_bounds__(NWAVES * 64, 2) hymba_fwd(Args args) {
    extern __shared__ __attribute__((aligned(16))) unsigned char lds[];
    LAS unsigned char* L = (LAS unsigned char*)lds;
    const int G = gridDim.x, bx = blockIdx.x, vcu = (G % 8 == 0) ? (bx % 8) * (G / 8) + bx / 8 : bx;
    for (int u = threadIdx.x; u < (LDS_BYTES - LDSCTL_OFF) / 4; u += NWAVES * 64) ((LAS unsigned*)(L + LDSCTL_OFF))[u] = 0u;
    __syncthreads();
    XcdBarrier bar = xcd_barrier_post((unsigned*)(((KA)__builtin_amdgcn_kernarg_segment_ptr())->ws + WS_CTL) + CW_BAR, (volatile LAS unsigned*)(L + MISC_OFF) + 8);
#define GRID_BAR() xcd_barrier(bar)
#ifndef PHM
#define PHM 0xFFFF
#endif
#define PH(k) if constexpr (((PHM) >> (k)) & 1)
    PH(0) { PHASE_LOCALS();
        float* MOD = (float*)(ws + WS_MOD);
        for (int job = bx; job < 256; job += G) {
            if (job < 192) ada_item(ka, job, L, tid, wave, lane, MOD);
            else s5_gen_group(ka, job - 192, L, tid, (bf16*)(ws + WS_BTM), (bf16*)(ws + WS_BTE), (float*)(ws + WS_A16));
        }
        __syncthreads();
        LAS float* scr = (LAS float*)(L + wave * 16384);
        for (int it = gw; it < TI_ALL; it += NGW) {
            int r = it;
            if (r < TI_IN) { const int kb = r / (INW / 32), nb = r % (INW / 32); p0_transpose_item(ka->in[I_WIN], DM, INW, (bf16*)(ws + WS_WIN), nb * 32, scr, kb * 64, nb * 32, lane); continue; } r -= TI_IN;
            if (r < TI_GLU) { const int kb = r / 64, nb = r % 64, n0 = nb * 32; const int wrow0 = n0 < 1024 ? (n0 >> 7) * 256 + (n0 & 127) : ((n0 - 1024) >> 7) * 256 + 128 + (n0 & 127);
                p0_transpose_item(ka->in[I_WGLU], 1024, 2048, (bf16*)(ws + WS_WGLU), wrow0, scr, kb * 64, n0, lane); continue; } r -= TI_GLU;
            if (r < TI_OUT) { const int kb = r / (DM / 32), nb = r % (DM / 32); p0_transpose_item(ka->in[I_WOUT], DM, DM, (bf16*)(ws + WS_WOUT), nb * 32, scr, kb * 64, nb * 32, lane); continue; } r -= TI_OUT;
            if (r < TI_FF1) { const int kb = r / (DFF / 32), nb = r % (DFF / 32); p0_transpose_item(ka->in[I_WFF1], DM, DFF, (bf16*)(ws + WS_WFF1), nb * 32, scr, kb * 64, nb * 32, lane); continue; } r -= TI_FF1;
            { const int kb = r / (DM / 32), nb = r % (DM / 32); p0_transpose_item(ka->in[I_WFF2], DFF, DM, (bf16*)(ws + WS_WFF2), nb * 32, scr, kb * 64, nb * 32, lane); }
        }
        float* ROPE = (float*)(ws + WS_ROPE);
        for (int e = bx * 512 + tid; e < SEQ * 8; e += G * 512) {
            const int pos = e >> 3, i = e & 7;
            const float inv = (float)d_exp(-(double)i * 0.125 * 13.122363377404328);
            const float ang = (float)pos * inv; double sn, cs; d_sincos((double)ang, sn, cs);
            ROPE[pos * 16 + i] = (float)cs; ROPE[pos * 16 + 8 + i] = (float)sn;
        }
    }
    GRID_BAR();
    PH(1) { PHASE_LOCALS(); norm_mod_pass<0>(ka, (const float*)(ws + WS_MOD), out + O_Y, (bf16*)(ws + WS_H), gw, NGW, lane); }
    GRID_BAR();
    PH(2) { PHASE_LOCALS();
        pg8::Gemm g{(bf16*)(ws + WS_H), (bf16*)(ws + WS_WIN), DM, DM, DM}; pg8::StaticOrder S; S.init(M, INW, G, bx);
        epi::EpiInProj E{(bf16*)(ws + WS_Q), (bf16*)(ws + WS_K), (bf16*)(ws + WS_V), (bf16*)(ws + WS_UR), out, (const float*)(ws + WS_ROPE)};
        pg8::gemm_phase<epi::EpiInProj, pg8::StaticOrder, true, true>(L, g, S, E);
    }
    GRID_BAR();
    PH(3) { PHASE_LOCALS();
        pg8::Gemm g{(bf16*)(ws + WS_UR), (bf16*)(ws + WS_BTE), S5K, 256, 256}; epi::S5Order S{G, bx};
        epi::EpiS5E E{(float*)(ws + WS_E)};
        pg8::gemm_phase<epi::EpiS5E, epi::S5Order, true, true>(L, g, S, E);
    }
    GRID_BAR();
    PH(4) { PHASE_LOCALS(); carry_scan(ka, (const float*)(ws + WS_E), (bf16*)(ws + WS_UR), (const float*)(ws + WS_A16), out, L, vcu, G, wave, lane); }
    GRID_BAR();
    PH(5) { PHASE_LOCALS();
        pg8::Gemm g{(bf16*)(ws + WS_UR), (bf16*)(ws + WS_BTM), S5K, S5K, S5K}; epi::S5Order S{G, bx};
        epi::EpiS5Main E{(bf16*)(ws + WS_Z)};
        pg8::gemm_phase<epi::EpiS5Main, epi::S5Order, true, true>(L, g, S, E);
    }
    PH(6) { PHASE_LOCALS();
        bf16 *QB = (bf16*)(ws + WS_Q), *KB = (bf16*)(ws + WS_K), *VB = (bf16*)(ws + WS_V), *MIX = (bf16*)(ws + WS_MIX);
        float lam;
        { const float a1 = wave_sum(ka->in[I_LQ1][lane] * ka->in[I_LK1][lane]), a2 = wave_sum(ka->in[I_LQ2][lane] * ka->in[I_LK2][lane]); lam = __expf(a1) - __expf(a2) + LAM_INIT; }
        const float* gsub = ka->in[I_GSUB];
#ifndef NO_SAMPLE_ATT
        for (int su = vcu; su < NBS * NH; su += G) {
            const int bs = su >> 3, h = su & 7; const bool active = wave < 4; const int c = (wave >> 1) & 1, rb = wave & 1;
            const size_t qrow = (size_t)MP + bs * DSEQ + rb * 32;
            att::attn_unit<float, 1>(QB + qrow * AW + h * 128 + c * 64,
                                     ka->in[I_CK] + (size_t)bs * PAST * AW + h * 128, ka->in[I_CV] + (size_t)bs * PAST * AW + h * 128,
                                     out + O_KS + (size_t)bs * DSEQ * AW + h * 128, out + O_VS + (size_t)bs * DSEQ * AW + h * 128,
                                     PAST / 64, PAST / 64 + 2, active, c, rb, PAST / 64 + 1, lam, gsub, MIX + qrow * DM + h * 128, (char*)lds);
        }
#endif
#ifndef NO_PROMPT_ATT
        for (int pu = vcu; pu < NBP * NH * 8; pu += G) {
            const int bh = pu >> 3, s = pu & 7, b = bh >> 3, h = bh & 7; const int c = wave >> 2, rb = wave & 3;
            for (int i = 0; i < 8; ++i) {
                const int qb2 = (i >> 1) * 16 + ((i & 1) ? 15 - s : s);
                const size_t qrow = (size_t)b * SEQ + qb2 * 128 + rb * 32;
                const bf16* Kh = KB + (size_t)b * SEQ * AW + h * 128; const bf16* Vh = VB + (size_t)b * SEQ * AW + h * 128;
                att::attn_unit<bf16, 2>(QB + qrow * AW + h * 128 + c * 64, Kh, Vh, Kh, Vh, 2 * qb2 + 2, 2 * qb2 + 2, true, c, rb, 2 * qb2 + (rb >> 1) + 1, lam, gsub, MIX + qrow * DM + h * 128, (char*)lds);
            }
        }
#endif
    }
    GRID_BAR();
    PH(7) { PHASE_LOCALS();
        pg8::Gemm g{(bf16*)(ws + WS_Z), (bf16*)(ws + WS_WGLU), 1024, 1024, 1024}; pg8::StaticOrder S; S.init(M, 2048, G, bx);
        epi::EpiGlu E{(bf16*)(ws + WS_MIX), ka->in[I_BGLU]};
        pg8::gemm_phase<epi::EpiGlu, pg8::StaticOrder, true, true>(L, g, S, E);
    }
    GRID_BAR();
    PH(8) { PHASE_LOCALS();
        pg8::Gemm g{(bf16*)(ws + WS_MIX), (bf16*)(ws + WS_WOUT), DM, DM, DM}; pg8::StaticOrder S; S.init(M, DM, G, bx);
        epi::EpiOut E{ka->in[I_XP], ka->in[I_XS], out + O_Y, (const float*)(ws + WS_MOD)};
        pg8::gemm_phase<epi::EpiOut, pg8::StaticOrder, true, true>(L, g, S, E);
    }
    GRID_BAR();
    PH(9) { PHASE_LOCALS(); norm_mod_pass<1>(ka, (const float*)(ws + WS_MOD), out + O_Y, (bf16*)(ws + WS_H), gw, NGW, lane); }
    GRID_BAR();
    PH(10) { PHASE_LOCALS();
        pg8::Gemm g{(bf16*)(ws + WS_H), (bf16*)(ws + WS_WFF1), DM, DM, DM}; pg8::StaticOrder S; S.init(M, DFF, G, bx);
        epi::EpiFF1 E{(bf16*)(ws + WS_HID)};
        pg8::gemm_phase<epi::EpiFF1, pg8::StaticOrder, true, true>(L, g, S, E);
    }
    GRID_BAR();
    PH(11) { PHASE_LOCALS();
        pg8::Gemm g{(bf16*)(ws + WS_HID), (bf16*)(ws + WS_WFF2), DFF, DFF, DFF}; pg8::StaticOrder S; S.init(M, DM, G, bx);
        epi::EpiFF2 E{out + O_Y, (const float*)(ws + WS_MOD)};
        pg8::gemm_phase<epi::EpiFF2, pg8::StaticOrder, true, true>(L, g, S, E);
    }
    GRID_BAR();
    PH(12) { PHASE_LOCALS(); final_norm_pass(ka, out + O_Y, gw, NGW, lane); }
#undef GRID_BAR
}

extern "C" void kernel_launch(void* const* d_in, const int* in_sizes, int n_in, void* d_out, int out_size, void* d_ws, size_t ws_size, hipStream_t stream) {
    static int grid = 0;
    if (grid == 0) {
        if (n_in != N_IN || (size_t)out_size != O_END || ws_size < WS_END) { fprintf(stderr, "kernel_launch: shape mismatch: n_in %d out %d ws %zu (need %d, %zu, >= %zu); nothing launched\n", n_in, out_size, ws_size, (int)N_IN, (size_t)O_END, (size_t)WS_END); grid = -1; return; }
        int dev = 0, cus = 0, per_cu = 0;
        if (hipGetDevice(&dev) != hipSuccess || hipDeviceGetAttribute(&cus, hipDeviceAttributeMultiprocessorCount, dev) != hipSuccess) { fprintf(stderr, "kernel_launch: device query failed\n"); grid = -1; return; }
        if (hipFuncSetAttribute((const void*)hymba_fwd, hipFuncAttributeMaxDynamicSharedMemorySize, LDS_BYTES) != hipSuccess) { fprintf(stderr, "kernel_launch: hipFuncSetAttribute failed\n"); grid = -1; return; }
        if (hipOccupancyMaxActiveBlocksPerMultiprocessor(&per_cu, (const void*)hymba_fwd, NWAVES * 64, LDS_BYTES) != hipSuccess || per_cu < 1) { fprintf(stderr, "kernel_launch: occupancy query reports %d workgroups per CU\n", per_cu); }
        (void)hipGetLastError();
        grid = cus;
    }
    if (grid < 0) return;
    if (hipMemsetAsync((char*)d_ws + WS_CTL, 0, CTL_ZERO_BYTES, stream) != hipSuccess) { fprintf(stderr, "kernel_launch: memset failed\n"); return; }
    Args a{};
    for (int i = 0; i < N_IN; ++i) a.in[i] = (const float*)d_in[i];
    a.out = (float*)d_out; a.ws = (unsigned char*)d_ws;
    hipLaunchKernelGGL(hymba_fwd, dim3(grid), dim3(NWAVES * 64), LDS_BYTES, stream, a);
    const hipError_t le = hipPeekAtLastError();
    if (le != hipSuccess) fprintf(stderr, "kernel_launch: launch failed: %s\n", hipGetErrorName(le));
}
```

```cpp
#include <hip/hip_runtime.h>
#include <cstdio>
#include <cstdint>
#include <type_traits>
namespace pg8 {
#define PG8_LAS __attribute__((address_space(3)))
typedef unsigned short bf16_t;
typedef short bf16x8 __attribute__((ext_vector_type(8)));
typedef float f32x4 __attribute__((ext_vector_type(4)));
typedef unsigned u32x4 __attribute__((ext_vector_type(4)));
constexpr int BM = 256, BK = 64, HALF = 128, HTB = HALF * BK * 2  , STAGE_BYTES = 8 * HTB, NXCD = 8, WGM = 8;

__host__ __device__ __forceinline__ int lds_byte(int r, int c) { const int st = (r >> 4) * 2 + (c >> 5), rr = r & 15, cc = c & 31, ob = rr * 64 + cc * 2; return st * 1024 + (ob ^ (((ob >> 9) & 1) << 5)); }
__host__ __device__ __forceinline__ void stage_rc(int b, int& R, int& C) { const int st = b / 1024, sb = b % 1024, swz = sb ^ (((sb >> 9) & 1) << 5); R = (st >> 1) * 16 + swz / 64; C = (st & 1) * 32 + (swz % 64) / 2; }
__host__ __device__ __forceinline__ int perm32(int rho) { const int n = rho >> 4, i = rho & 15; return 8 * (i >> 2) + 4 * n + (i & 3); }

struct Unit { int pm, pn, k0, nk; };
struct Gemm { const bf16_t* A; const bf16_t* Bt; int lda, ldb, K; };

struct StaticOrder {
    int nM, nN, nwg, G, c;
    __host__ __device__ void init(int M, int N, int G_, int c_) { nM = M / BM; nN = N / BM; nwg = nM * nN; G = G_; c = c_; }
    __host__ __device__ bool next(int i, Unit& u) const {
        const long L = (long)i * G + c; if (L >= nwg) return false;
        int wgid = (int)L; { const int q = nwg / NXCD, r = nwg % NXCD, xcd = wgid % NXCD, off = wgid / NXCD; wgid = (xcd < r ? xcd * (q + 1) : r * (q + 1) + (xcd - r) * q) + off; }
        const int nig = WGM * nN, gid = wgid / nig, fm = gid * WGM, gsz = (nM - fm) < WGM ? (nM - fm) : WGM;
        u.pm = fm + ((wgid % nig) % gsz); u.pn = (wgid % nig) / gsz; u.k0 = 0; u.nk = 0; return true;
    }
    __device__ __forceinline__ void a_ready(const Unit&) const {}
    __device__ __forceinline__ void done(const Unit&) const {}
};

__device__ __forceinline__ unsigned cvt_pk_bf16(float lo, float hi) { unsigned r; asm volatile("v_cvt_pk_bf16_f32 %0, %1, %2" : "=v"(r) : "v"(lo), "v"(hi)); return r; }
template <class Epi, class Sched, bool ALIGN_EPI = false, bool SP2 = false, bool F8 = false>
__device__ __forceinline__ void gemm_phase(PG8_LAS unsigned char* lds, const Gemm g, const Sched& S, const Epi& E) {
    int tid = threadIdx.x; asm volatile("" : "+v"(tid));
    const int wid = __builtin_amdgcn_readfirstlane(tid >> 6), lane = tid & 63, wr = wid >> 2, wc = wid & 3, fr = lane & 15, fq = lane >> 4;
    constexpr int ESZ = F8 ? 1 : 2;
    const int ntfull = g.K * ESZ / 128;
    unsigned voffA[2], voffB[2];
#pragma unroll
    for (int i = 0; i < 2; ++i) { int R, C; stage_rc(tid * 16 + i * 8192, R, C); const int Rb = Epi::PERM ? ((R & ~31) + perm32(R & 31)) : R;
        voffA[i] = (unsigned)(R * g.lda * ESZ + C * 2); voffB[i] = (unsigned)(Rb * g.ldb * ESZ + C * 2); }
    const size_t kstep = (size_t)(BK * 2);
    const size_t hstepA = (size_t)HALF * g.lda * ESZ, hstepB = (size_t)HALF * g.ldb * ESZ;
    const size_t tstepA = 2 * hstepA, tstepB = 2 * hstepB;
    const unsigned ldsw = (unsigned)wid * 1024u;
    const int aoff = lds_byte(wr * 64 + fr, fq * 8), boff = lds_byte(wc * 32 + fr, fq * 8);
#define PG8_SA(b, h) (((b) * 2 + (h)) * HTB)
#define PG8_SB(b, h) ((4 + (b) * 2 + (h)) * HTB)
#define PG8_STAGE(bufoff, gbase, voff) do { _Pragma("unroll") for (int _i = 0; _i < 2; ++_i) \
        __builtin_amdgcn_global_load_lds((const unsigned*)((const char*)(gbase) + (voff)[_i]), (PG8_LAS unsigned*)(lds + (bufoff) + ldsw + _i * 8192), 16, 0, 0); } while (0)
#define PG8_LDA(dst, b, h) do { _Pragma("unroll") for (int m = 0; m < 4; ++m) _Pragma("unroll") for (int k = 0; k < 2; ++k) dst[m][k] = *(const PG8_LAS bf16x8*)(lds + PG8_SA(b, h) + aoff + m * 2048 + k * 1024); } while (0)
#define PG8_LDB(dst, b, h) do { _Pragma("unroll") for (int n = 0; n < 2; ++n) _Pragma("unroll") for (int k = 0; k < 2; ++k) dst[n][k] = *(const PG8_LAS bf16x8*)(lds + PG8_SB(b, h) + boff + n * 2048 + k * 1024); } while (0)
#define PG8_MMA(ai, bj, At, Bt) do { __builtin_amdgcn_s_setprio(1); _Pragma("unroll") for (int m = 0; m < 4; ++m) _Pragma("unroll") for (int n = 0; n < 2; ++n) { \
        if constexpr (F8) { typedef int v4i_ __attribute__((ext_vector_type(4))); typedef int v8i_ __attribute__((ext_vector_type(8))); \
            const v8i_ bq_ = __builtin_shufflevector(__builtin_bit_cast(v4i_, Bt[n][0]), __builtin_bit_cast(v4i_, Bt[n][1]), 0, 1, 2, 3, 4, 5, 6, 7); \
            const v8i_ aq_ = __builtin_shufflevector(__builtin_bit_cast(v4i_, At[m][0]), __builtin_bit_cast(v4i_, At[m][1]), 0, 1, 2, 3, 4, 5, 6, 7); \
            asm volatile("v_mfma_f32_16x16x128_f8f6f4 %0, %1, %2, %0" : "+v"(acc[ai][bj][m][n]) : "v"(bq_), "v"(aq_)); } \
        else { _Pragma("unroll") for (int k = 0; k < 2; ++k) acc[ai][bj][m][n] = __builtin_amdgcn_mfma_f32_16x16x32_bf16(Bt[n][k], At[m][k], acc[ai][bj][m][n], 0, 0, 0); } } \
        __builtin_amdgcn_s_setprio(0); } while (0)
#define PG8_WAIT_V(n) asm volatile("s_waitcnt vmcnt(" #n ")" ::: "memory")
#define PG8_WAIT_L(n) asm volatile("s_waitcnt lgkmcnt(" #n ")" ::: "memory")
#define PG8_BAR __builtin_amdgcn_s_barrier()
#define PG8_SCHED __builtin_amdgcn_sched_barrier(0)
    Unit cur, nxt; int ui = 0;
    if (!S.next(0, cur)) return;
    f32x4 acc[2][2][4][2];
#pragma unroll
    for (int a = 0; a < 2; ++a)
#pragma unroll
        for (int b = 0; b < 2; ++b)
#pragma unroll
            for (int m = 0; m < 4; ++m)
#pragma unroll
                for (int n = 0; n < 2; ++n) acc[a][b][m][n] = (f32x4){0.f, 0.f, 0.f, 0.f};
    bf16x8 At[4][2], B0[2][2], B1[2][2];
    const char* cA = (const char*)g.A + (size_t)cur.pm * tstepA + (size_t)cur.k0 * kstep; const char* cB = (const char*)g.Bt + (size_t)cur.pn * tstepB + (size_t)cur.k0 * kstep;
    int nt = cur.nk ? cur.nk : ntfull;
    S.a_ready(cur);
    if constexpr (SP2) {
        PG8_STAGE(PG8_SB(0, 0), cB, voffB); PG8_STAGE(PG8_SB(0, 1), cB + hstepB, voffB); PG8_STAGE(PG8_SA(0, 0), cA, voffA); PG8_STAGE(PG8_SA(0, 1), cA + hstepA, voffA);
        if (wr == 1) PG8_BAR;
        PG8_WAIT_V(2); PG8_BAR;
        PG8_STAGE(PG8_SB(1, 0), cB + kstep, voffB); PG8_STAGE(PG8_SA(1, 0), cA + kstep, voffA); PG8_STAGE(PG8_SB(1, 1), cB + hstepB + kstep, voffB);
        PG8_WAIT_V(6); PG8_BAR;
    } else {
        PG8_STAGE(PG8_SB(0, 0), cB, voffB); PG8_STAGE(PG8_SA(0, 0), cA, voffA); PG8_STAGE(PG8_SB(0, 1), cB + hstepB, voffB); PG8_STAGE(PG8_SA(0, 1), cA + hstepA, voffA);
        if (wr == 1) PG8_BAR;
        PG8_WAIT_V(4); PG8_BAR;
        PG8_STAGE(PG8_SB(1, 0), cB + kstep, voffB); PG8_STAGE(PG8_SA(1, 0), cA + kstep, voffA); PG8_STAGE(PG8_SB(1, 1), cB + hstepB + kstep, voffB);
        PG8_WAIT_V(6); PG8_BAR;
    }
    for (;;) {
        const bool has_next = S.next(ui + 1, nxt);
        const char* nA = has_next ? (const char*)g.A + (size_t)nxt.pm * tstepA + (size_t)nxt.k0 * kstep : cA; const char* nB = has_next ? (const char*)g.Bt + (size_t)nxt.pn * tstepB + (size_t)nxt.k0 * kstep : cB;
#pragma unroll 1
        for (int t = 0; t < nt; t += 2) {
            const bool last = (t == nt - 2);
            const char* a1 = cA + (size_t)(t + 1) * kstep;
            const char* a2 = last ? nA : cA + (size_t)(t + 2) * kstep; const char* b2 = last ? nB : cB + (size_t)(t + 2) * kstep;
            const char* a3 = a2 + kstep; const char* b3 = b2 + kstep;
            if (last && has_next) S.a_ready(nxt);
            if constexpr (SP2) {
            PG8_LDB(B0, 0, 0); PG8_LDB(B1, 0, 1); PG8_SCHED; PG8_LDA(At, 0, 0); PG8_STAGE(PG8_SA(1, 1), a1 + hstepA, voffA);
            PG8_WAIT_V(8); PG8_WAIT_L(0); PG8_BAR; PG8_MMA(0, 0, At, B0); PG8_MMA(0, 1, At, B1); PG8_BAR; PG8_SCHED;
            PG8_LDA(At, 0, 1); PG8_STAGE(PG8_SB(0, 0), b2, voffB); PG8_STAGE(PG8_SB(0, 1), b2 + hstepB, voffB); PG8_STAGE(PG8_SA(0, 0), a2, voffA);
            PG8_WAIT_V(8); PG8_WAIT_L(0); PG8_BAR; PG8_MMA(1, 0, At, B0); PG8_MMA(1, 1, At, B1); PG8_BAR; PG8_SCHED;
            PG8_LDB(B0, 1, 0); PG8_LDB(B1, 1, 1); PG8_SCHED; PG8_LDA(At, 1, 0); PG8_STAGE(PG8_SA(0, 1), a2 + hstepA, voffA);
            PG8_WAIT_V(8); PG8_WAIT_L(0); PG8_BAR; PG8_MMA(0, 0, At, B0); PG8_MMA(0, 1, At, B1); PG8_BAR; PG8_SCHED;
            PG8_LDA(At, 1, 1); PG8_STAGE(PG8_SB(1, 0), b3, voffB); PG8_STAGE(PG8_SB(1, 1), b3 + hstepB, voffB); PG8_STAGE(PG8_SA(1, 0), a3, voffA);
            PG8_WAIT_V(8); PG8_WAIT_L(0); PG8_BAR; PG8_MMA(1, 0, At, B0); PG8_MMA(1, 1, At, B1); PG8_BAR; PG8_SCHED;
            } else {
            PG8_LDB(B0, 0, 0); PG8_SCHED; PG8_LDA(At, 0, 0); PG8_STAGE(PG8_SA(1, 1), a1 + hstepA, voffA);
            PG8_WAIT_L(8); PG8_BAR; PG8_WAIT_L(0); PG8_MMA(0, 0, At, B0); PG8_BAR; PG8_SCHED;
            PG8_LDB(B1, 0, 1); PG8_STAGE(PG8_SB(0, 0), b2, voffB);
            PG8_BAR; PG8_WAIT_L(0); PG8_MMA(0, 1, At, B1); PG8_BAR;
            PG8_LDA(At, 0, 1); PG8_STAGE(PG8_SA(0, 0), a2, voffA);
            PG8_BAR; PG8_WAIT_L(0); PG8_MMA(1, 0, At, B0); PG8_BAR; PG8_SCHED;
            PG8_STAGE(PG8_SB(0, 1), b2 + hstepB, voffB);
            PG8_WAIT_V(6); PG8_BAR; PG8_MMA(1, 1, At, B1); PG8_BAR;
            PG8_LDB(B0, 1, 0); PG8_SCHED; PG8_LDA(At, 1, 0); PG8_STAGE(PG8_SA(0, 1), a2 + hstepA, voffA);
            PG8_WAIT_L(8); PG8_BAR; PG8_WAIT_L(0); PG8_MMA(0, 0, At, B0); PG8_BAR; PG8_SCHED;
            PG8_LDB(B1, 1, 1); PG8_STAGE(PG8_SB(1, 0), b3, voffB);
            PG8_BAR; PG8_WAIT_L(0); PG8_MMA(0, 1, At, B1); PG8_BAR;
            PG8_LDA(At, 1, 1); PG8_STAGE(PG8_SA(1, 0), a3, voffA);
            PG8_BAR; PG8_WAIT_L(0); PG8_MMA(1, 0, At, B0); PG8_BAR; PG8_SCHED;
            PG8_STAGE(PG8_SB(1, 1), b3 + hstepB, voffB);
            PG8_WAIT_V(6); PG8_BAR; PG8_MMA(1, 1, At, B1); PG8_BAR;
            }
        }
        if constexpr (ALIGN_EPI) { if (wr == 0) PG8_BAR; }
        if constexpr (F8) { PG8_SCHED; asm volatile("s_nop 15\n\ts_nop 15" ::: "memory"); PG8_SCHED; }
        if constexpr (!Epi::AFTER_DRAIN) { E(acc, cur, wr, wc, fr, fq); S.done(cur); }
        if (!has_next) break;
#pragma unroll
        for (int a = 0; a < 2; ++a)
#pragma unroll
            for (int b = 0; b < 2; ++b)
#pragma unroll
                for (int m = 0; m < 4; ++m)
#pragma unroll
                    for (int n = 0; n < 2; ++n) acc[a][b][m][n] = (f32x4){0.f, 0.f, 0.f, 0.f};
        cur = nxt; cA = nA; cB = nB; ++ui; nt = cur.nk ? cur.nk : ntfull;
        if constexpr (ALIGN_EPI) { if (wr == 1) PG8_BAR; }
    }
    PG8_WAIT_V(0);
    if constexpr (!ALIGN_EPI) { if (wr == 0) PG8_BAR; }
    PG8_BAR;
    if constexpr (Epi::AFTER_DRAIN) { E.fused(acc, cur, wr, wc, fr, fq, lds, wid, lane); S.done(cur); }
#undef PG8_SA
#undef PG8_SB
#undef PG8_STAGE
#undef PG8_LDA
#undef PG8_LDB
#undef PG8_MMA
#undef PG8_WAIT_V
#undef PG8_WAIT_L
#undef PG8_BAR
#undef PG8_SCHED
}
}
#define GAS __attribute__((address_space(1)))
#define LAS __attribute__((address_space(3)))
typedef unsigned short bf16;
typedef unsigned v4u __attribute__((ext_vector_type(4)));
typedef float f32x4 __attribute__((ext_vector_type(4)));
typedef short bf16x8 __attribute__((ext_vector_type(8)));
typedef GAS unsigned gu32;
typedef GAS unsigned long long gu64;
#define RLX_AGENT __ATOMIC_RELAXED, __HIP_MEMORY_SCOPE_AGENT
#define LDS_WAIT() asm volatile("s_waitcnt lgkmcnt(0)" ::: "memory")
#define VM_WAIT() asm volatile("s_waitcnt vmcnt(0)" ::: "memory")
__device__ __forceinline__ unsigned long long rt() { return __builtin_amdgcn_s_memrealtime(); }
__device__ __forceinline__ unsigned f2bf(float f) { unsigned u = __builtin_bit_cast(unsigned, f); return (u + 0x7fffu + ((u >> 16) & 1u)) >> 16; }
__device__ __forceinline__ unsigned pk2(float lo, float hi) { return f2bf(lo) | (f2bf(hi) << 16); }
#define XB_TMO      128
#define XB_XCNT(j)  (256  + 64 * (j))
#define XB_XSUB(j)  (1280 + 64 * (j))
#define XB_XGEN(j)  (2304 + 64 * (j))
#define XB_TOP      3328
#define XB_TOPGEN   3392
#define XCD_BAR_WORDS 3456
#define XB_SPIN_CAP (1u << 18)

__device__ __forceinline__ unsigned xb_ld(unsigned* p)              { return __hip_atomic_load(p, __ATOMIC_RELAXED, __HIP_MEMORY_SCOPE_AGENT); }
__device__ __forceinline__ unsigned xb_add(unsigned* p, unsigned v) { return __hip_atomic_fetch_add(p, v, __ATOMIC_RELAXED, __HIP_MEMORY_SCOPE_AGENT); }
__device__ __forceinline__ unsigned xb_xcc_id() { return (unsigned)__builtin_amdgcn_s_getreg((3 << 11) | 20) & 0xFu; }
#define XB_SPIN(cond, bar) do { unsigned _sp = 0; while (cond) { __builtin_amdgcn_s_sleep(1); \
    if ((++_sp & 255u) == 0u) { if (xb_ld(&(bar)[XB_TMO])) break; if (_sp > XB_SPIN_CAP) { atomicAdd(&(bar)[XB_TMO], 1u); break; } } } } while (0)

struct XcdBarrier {
    unsigned* bar; unsigned x;
    volatile LAS unsigned* st;
};

__device__ __forceinline__ XcdBarrier xcd_barrier_post(unsigned* bar, volatile LAS unsigned* st) {
    XcdBarrier b; b.bar = bar; b.x = xb_xcc_id(); b.st = st;
    if (threadIdx.x == 0) (void)xb_add(&bar[XB_XCNT(b.x)], 1u);
    return b;
}
__device__ __forceinline__ void xcd_barrier_complete(unsigned* bar, unsigned x, unsigned& nloc, unsigned& nx) {
    const unsigned G = gridDim.x * gridDim.y * gridDim.z;
    unsigned sum, cnt, mine, sp = 0u;
    for (;;) {
        sum = 0u; cnt = 0u; mine = 0u;
#pragma unroll
        for (unsigned j = 0; j < 16; ++j) { const unsigned c = xb_ld(&bar[XB_XCNT(j)]); sum += c; cnt += (c > 0u) ? 1u : 0u; mine = (j == x) ? c : mine; }
        if (sum == G) break;
        __builtin_amdgcn_s_sleep(1);
        if ((++sp & 255u) == 0u) { if (xb_ld(&bar[XB_TMO])) break; if (sp > XB_SPIN_CAP) { atomicAdd(&bar[XB_TMO], 1u); break; } }
    }
    nloc = mine > 0u ? mine : 1u; nx = cnt > 0u ? cnt : 1u;
}

__device__ __forceinline__ void xcd_barrier(const XcdBarrier& b) {
    asm volatile("s_waitcnt vmcnt(0)" ::: "memory");
    __syncthreads();
    if (threadIdx.x == 0) {
        unsigned* bar = b.bar;
        __builtin_amdgcn_s_waitcnt(0);
        unsigned nloc = b.st[0], nx = b.st[1];
        if (nloc == 0u) { xcd_barrier_complete(bar, b.x, nloc, nx); b.st[0] = nloc; b.st[1] = nx; }
        const unsigned old = xb_add(&bar[XB_XSUB(b.x)], 1u);
        const unsigned gen = old / nloc;
        if (old + 1u == (gen + 1u) * nloc) {
            __builtin_amdgcn_fence(__ATOMIC_RELEASE, "agent");
            asm volatile("s_waitcnt vmcnt(0)" ::: "memory");
            const unsigned og = xb_add(&bar[XB_TOP], 1u);
            const unsigned tg = og / nx;
            if (og + 1u == (tg + 1u) * nx) xb_add(&bar[XB_TOPGEN], 1u);
            else XB_SPIN(xb_ld(&bar[XB_TOPGEN]) == tg, bar);
            __builtin_amdgcn_fence(__ATOMIC_ACQUIRE, "agent");
            xb_add(&bar[XB_XGEN(b.x)], 1u);
            asm volatile("s_waitcnt vmcnt(0)" ::: "memory");
        } else {
            XB_SPIN(xb_ld(&bar[XB_XGEN(b.x)]) == gen, bar);
            __builtin_amdgcn_fence(__ATOMIC_ACQUIRE, "agent");
            asm volatile("s_waitcnt vmcnt(0)" ::: "memory");
        }
    }
    __syncthreads();
}

constexpr int DM = 2048, NBP = 4, SEQ = 8192, NBS = 32, DSEQ = 64, PAST = 2048;
constexpr int MP = NBP * SEQ, MS = NBS * DSEQ, M = MP + MS;
constexpr int AW = 1024, NH = 8, HD = 64, VD = 128, INW = 4096, DFF = 8192;
constexpr int SG = 64, SP = 64, SH = 16;
constexpr int TS = 16;
constexpr int NROW = M / TS, S5NT = 9, NROWP = S5NT * 256, S5K = 384;
constexpr int NMOD = 36, MODW = 6 * DM;
constexpr float RMS_EPS = 1e-6f;
constexpr float LAM_INIT = 0.2f;
constexpr size_t O_Y = 0, O_KP = (size_t)M * DM, O_VP = O_KP + (size_t)MP * AW, O_SRP = O_VP + (size_t)MP * AW, O_SIP = O_SRP + (size_t)NBP * SG * SP,
                 O_KS = O_SIP + (size_t)NBP * SG * SP, O_VS = O_KS + (size_t)MS * AW, O_SRS = O_VS + (size_t)MS * AW, O_SIS = O_SRS + (size_t)NBS * SG * SP, O_END = O_SIS + (size_t)NBS * SG * SP;
static_assert(O_END == 142901248, "output size");
enum { I_XP = 0, I_XS, I_CP, I_CS, I_CK, I_CV, I_SRE, I_SIM, I_WADA, I_BADA, I_GMIX, I_WIN, I_LQ1, I_LK1, I_LQ2, I_LK2, I_GSUB, I_LRE, I_LIM, I_LDT, I_BRE, I_BIM, I_CRE, I_CIM, I_SD, I_WGLU, I_BGLU, I_WOUT, I_GFFN, I_WFF1, I_WFF2, I_GFIN, N_IN };
static_assert(N_IN == 32, "inputs");

constexpr size_t MiB = 1u << 20;
constexpr size_t WS_CTL = 0, CTL_ZERO_BYTES = 1 * MiB;
constexpr size_t WS_A16 = 1 * MiB;
constexpr size_t WS_ROPE = 2 * MiB;
constexpr size_t WS_MOD = 3 * MiB;
constexpr size_t WS_WIN = 8 * MiB, WS_WGLU = 24 * MiB, WS_WOUT = 28 * MiB, WS_WFF1 = 36 * MiB, WS_WFF2 = 68 * MiB;
constexpr size_t WS_BTM = 100 * MiB;
constexpr size_t WS_BTE = 112 * MiB;
constexpr size_t WS_H = 120 * MiB;
constexpr size_t WS_E = WS_H, WS_Z = WS_H + 68 * MiB;
constexpr size_t WS_Q = 256 * MiB, WS_K = 324 * MiB, WS_V = 388 * MiB, WS_UR = 452 * MiB, WS_MIX = 560 * MiB;
constexpr size_t WS_C2 = 5 * MiB, WS_SHB = 7 * MiB;
constexpr size_t WS_X2 = 560 * MiB;
constexpr size_t WS_HID = 256 * MiB, WS_SLAB = 800 * MiB, WS_STAT = 864 * MiB, WS_END = 872 * MiB;
static_assert(WS_WIN + (size_t)INW * DM * 2 <= WS_WGLU && WS_WGLU + (size_t)2048 * 1024 * 2 <= WS_WOUT && WS_WOUT + (size_t)DM * DM * 2 <= WS_WFF1 && WS_WFF1 + (size_t)DFF * DM * 2 <= WS_WFF2 && WS_WFF2 + (size_t)DM * DFF * 2 <= WS_BTM, "ws map 1");
static_assert(WS_BTM + (size_t)SG * 256 * S5K * 2 <= WS_BTE && WS_BTE + (size_t)SG * 256 * 256 * 2 <= WS_H && WS_H + (size_t)M * DM * 2 <= WS_Q, "ws map 2");
static_assert((size_t)SG * NROW * 128 * 4 <= 68 * MiB && (size_t)M * AW * 2 <= 68 * MiB, "E|Z");
static_assert(WS_Q + (size_t)M * AW * 2 <= WS_K && WS_K + (size_t)MP * AW * 2 <= WS_V && WS_V + (size_t)MP * AW * 2 <= WS_UR && WS_UR + (size_t)SG * NROWP * S5K * 2 <= WS_MIX && WS_MIX + (size_t)M * DM * 2 <= WS_SLAB, "ws map 3");
static_assert(WS_HID + (size_t)M * DFF * 2 <= WS_SLAB && WS_SLAB + (size_t)4 * MS * DM * 4 <= WS_STAT && WS_STAT + (size_t)M * 32 * 4 <= WS_END && WS_C2 + (size_t)NMOD * DFF * 4 <= WS_SHB && WS_SHB + 64 * DM * 2 <= WS_WIN && WS_MOD + (size_t)NMOD * MODW * 4 <= WS_WIN, "ws map 4");
constexpr int CW_BAR = 4096;

constexpr int RING_BYTES = 135168;
constexpr int LDSCTL_OFF = RING_BYTES, MISC_OFF = LDSCTL_OFF + 320;
constexpr int LDS_BYTES = 147456;
static_assert(MISC_OFF + 128 <= LDS_BYTES, "LDS map");
constexpr int NWAVES = 8;

namespace epi {
constexpr float HID_SCALE = 8.0f, W2_SCALE = 64.0f;
constexpr float Z_SCALE = 16.0f, WGLU_SCALE = 32.0f;
constexpr float MIX_SCALE = 16.0f, WOUT_SCALE = 32.0f;
constexpr float ATT_SQ = 16.0f, ATT_SK = 16.0f, ATT_SV = 16.0f, ATT_SP = 16.0f;
__device__ __forceinline__ int vpos(int key) { return ((key >> 2) & 1) * 32 + (key >> 5) * 16 + ((key >> 3) & 3) * 4 + (key & 3); }
using pg8::f32x4; using pg8::u32x4; using pg8::Unit; using pg8::cvt_pk_bf16; using pg8::bf16_t;
typedef float (accT)[4];
__device__ __forceinline__ u32x4 pack8(const f32x4& a, const f32x4& b) { u32x4 w; w.x = cvt_pk_bf16(a[0], a[1]); w.y = cvt_pk_bf16(a[2], a[3]); w.z = cvt_pk_bf16(b[0], b[1]); w.w = cvt_pk_bf16(b[2], b[3]); return w; }
typedef unsigned u32x2 __attribute__((ext_vector_type(2)));
__device__ __forceinline__ u32x2 pack8_fp8(f32x4 a, f32x4 b, float s) {
#pragma unroll
    for (int j = 0; j < 4; ++j) { a[j] = fminf(fmaxf(a[j] * s, -448.f), 448.f); b[j] = fminf(fmaxf(b[j] * s, -448.f), 448.f); }
    int w0 = __builtin_amdgcn_cvt_pk_fp8_f32(a[0], a[1], 0, false); w0 = __builtin_amdgcn_cvt_pk_fp8_f32(a[2], a[3], w0, true);
    int w1 = __builtin_amdgcn_cvt_pk_fp8_f32(b[0], b[1], 0, false); w1 = __builtin_amdgcn_cvt_pk_fp8_f32(b[2], b[3], w1, true);
    return (u32x2){(unsigned)w0, (unsigned)w1}; }
__device__ __forceinline__ void atom_add4(float* p, const f32x4& v) {
#pragma unroll
    for (int j = 0; j < 4; ++j) __builtin_amdgcn_global_atomic_fadd_f32((__attribute__((address_space(1))) float*)(p + j), v[j]); }
__device__ __forceinline__ int batch_of_tile(int pm, int ai, int wr) { return pm < 128 ? (pm >> 5) : 4 + (pm - 128) * 4 + 2 * ai + wr; }

struct EpiInProj {
    static constexpr bool PERM = true, AFTER_DRAIN = false;
    unsigned char* Q8; unsigned char* K8; unsigned char* VT8; bf16_t* Ur; float* out; const float* rope;
    __device__ __forceinline__ void operator()(const f32x4 (&acc)[2][2][4][2], const Unit& u, int wr, int wc, int fr, int fq) const {
        const int sect = u.pn >> 2, colt = (u.pn & 3) * 256 + wc * 32 + 8 * fq;
        const bool smp = u.pm >= 128;
        const int row0 = u.pm * 256 + wr * 64 + fr;
        if (sect <= 1) {
            const bool rot_wave = (wc & 1) == 0;
            float* okv = out + (smp ? O_KS : O_KP);
#pragma unroll
            for (int ai = 0; ai < 2; ++ai)
#pragma unroll
                for (int m = 0; m < 4; ++m) {
                    const int row = row0 + ai * 128 + m * 16;
                    const int pos = smp ? PAST + ((row - MP) & 63) : (row & (SEQ - 1));
                    f32x4 c0 = {1.f, 1.f, 1.f, 1.f}, c1 = c0, s0 = {0.f, 0.f, 0.f, 0.f}, s1 = s0;
                    if (rot_wave && fq < 2) { const f32x4* rp = (const f32x4*)(rope + (size_t)pos * 16); c0 = rp[0]; c1 = rp[1]; s0 = rp[2]; s1 = rp[3]; if (fq == 0) { s0 = -s0; s1 = -s1; } }
#pragma unroll
                    for (int bj = 0; bj < 2; ++bj) {
                        f32x4 v0 = acc[ai][bj][m][0], v1 = acc[ai][bj][m][1];
                        if (rot_wave) {
                            f32x4 p0, p1;
#pragma unroll
                            for (int j = 0; j < 4; ++j) { p0[j] = __shfl_xor(v0[j], 16); p1[j] = __shfl_xor(v1[j], 16); }
                            if (fq < 2) { v0 = v0 * c0 + p0 * s0; v1 = v1 * c1 + p1 * s1; }
                        }
                        const int col = colt + bj * 128;
                        if (sect == 0) { *(u32x2*)(Q8 + (size_t)row * AW + col) = pack8_fp8(v0, v1, ATT_SQ); }
                        else {
                            float* o = okv + (size_t)(smp ? row - MP : row) * AW + col; *(f32x4*)o = v0; *(f32x4*)(o + 4) = v1;
                            if (!smp) *(u32x2*)(K8 + (size_t)row * AW + col) = pack8_fp8(v0, v1, ATT_SK);
                        }
                    }
                }
        } else if (sect == 2) {
            float* okv = out + (smp ? O_VS : O_VP);
#pragma unroll
            for (int ai = 0; ai < 2; ++ai)
#pragma unroll
                for (int m = 0; m < 4; ++m) {
                    const int row = row0 + ai * 128 + m * 16;
#pragma unroll
                    for (int bj = 0; bj < 2; ++bj) {
                        const f32x4 v0 = acc[ai][bj][m][0], v1 = acc[ai][bj][m][1]; const int col = colt + bj * 128;
                        float* o = okv + (size_t)(smp ? row - MP : row) * AW + col; *(f32x4*)o = v0; *(f32x4*)(o + 4) = v1;
                        if (!smp) { const u32x2 w = pack8_fp8(v0, v1, ATT_SV); const int bb = row >> 13, t = row & (SEQ - 1), hh = col >> 7, dd = col & 127;
                            unsigned char* vp = VT8 + ((size_t)((bb * NH + hh) * (SEQ / 64) + (t >> 6)) * 128 + dd) * 64 + vpos(t & 63);
#pragma unroll
                            for (int x = 0; x < 8; ++x) vp[x * 64] = (unsigned char)(w[x >> 2] >> (8 * (x & 3))); }
                    }
                }
        } else {
#pragma unroll
            for (int ai = 0; ai < 2; ++ai)
#pragma unroll
                for (int m = 0; m < 4; ++m) {
                    const int row = row0 + ai * 128 + m * 16;
#pragma unroll
                    for (int bj = 0; bj < 2; ++bj) {
                        const int col = colt + bj * 128, g = col >> 4, h0 = col & 15;
                        *(u32x4*)(Ur + ((size_t)g * NROWP + (row >> 4)) * S5K + (row & 15) * 16 + h0) = pack8(acc[ai][bj][m][0], acc[ai][bj][m][1]);
                    }
                }
        }
    }
};

struct EpiS5E {
    static constexpr bool PERM = true, AFTER_DRAIN = false;
    float* E;
    __device__ __forceinline__ void operator()(const f32x4 (&acc)[2][2][4][2], const Unit& u, int wr, int wc, int fr, int fq) const {
        const int g = u.pn, rt = u.pm - S5NT * g, row0 = rt * 256 + wr * 64 + fr, col = wc * 32 + 8 * fq;
#pragma unroll
        for (int ai = 0; ai < 2; ++ai)
#pragma unroll
            for (int m = 0; m < 4; ++m) { const int row = row0 + ai * 128 + m * 16;
                if (row < NROW) { float* o = E + ((size_t)g * NROW + row) * 128 + col; *(f32x4*)o = acc[ai][0][m][0]; *(f32x4*)(o + 4) = acc[ai][0][m][1]; } }
    }
};

__device__ __forceinline__ float gelu_tanh(float x) {
    const float y = x * (0.7978845608028654f + 0.035677408136300125f * x * x);
    const float e = __builtin_amdgcn_exp2f(y * 2.8853900817779268f);
    return x - x * __builtin_amdgcn_rcpf(e + 1.0f);
}
struct EpiS5Main {
    static constexpr bool PERM = true, AFTER_DRAIN = false;
    unsigned char* Z;
    __device__ __forceinline__ void operator()(const f32x4 (&acc)[2][2][4][2], const Unit& u, int wr, int wc, int fr, int fq) const {
        const int g = u.pn, rt = u.pm - S5NT * g, row0 = rt * 256 + wr * 64 + fr;
#pragma unroll
        for (int ai = 0; ai < 2; ++ai)
#pragma unroll
            for (int m = 0; m < 4; ++m) { const int row = row0 + ai * 128 + m * 16;
                if (row < NROW) {
#pragma unroll
                    for (int bj = 0; bj < 2; ++bj) { const int n0 = bj * 128 + wc * 32 + 8 * fq, t = n0 >> 4, h0 = n0 & 15;
                        f32x4 v0 = acc[ai][bj][m][0], v1 = acc[ai][bj][m][1];
#pragma unroll
                        for (int j = 0; j < 4; ++j) { v0[j] = gelu_tanh(v0[j]); v1[j] = gelu_tanh(v1[j]); }
                        *(u32x2*)(Z + (size_t)(row * TS + t) * AW + g * 16 + h0) = pack8_fp8(v0, v1, Z_SCALE); __builtin_amdgcn_sched_barrier(0); } } }
    }
};

struct EpiGlu {
    static constexpr bool PERM = true, AFTER_DRAIN = false;
    unsigned char* MIX; const float* bglu;
    __device__ __forceinline__ void operator()(const f32x4 (&acc)[2][2][4][2], const Unit& u, int wr, int wc, int fr, int fq) const {
        const int row0 = u.pm * 256 + wr * 64 + fr, col = u.pn * 128 + wc * 32 + 8 * fq;
        const f32x4 bv0 = *(const f32x4*)(bglu + col), bv1 = *(const f32x4*)(bglu + col + 4), bg0 = *(const f32x4*)(bglu + 1024 + col), bg1 = *(const f32x4*)(bglu + 1024 + col + 4);
#pragma unroll
        for (int ai = 0; ai < 2; ++ai)
#pragma unroll
            for (int m = 0; m < 4; ++m) { const int row = row0 + ai * 128 + m * 16;
                constexpr float RS = 1.0f / (Z_SCALE * WGLU_SCALE);
                f32x4 v0 = acc[ai][0][m][0] * RS + bv0, v1 = acc[ai][0][m][1] * RS + bv1; const f32x4 g0 = acc[ai][1][m][0] * RS + bg0, g1 = acc[ai][1][m][1] * RS + bg1;
#pragma unroll
                for (int j = 0; j < 4; ++j) { v0[j] = v0[j] * __builtin_amdgcn_rcpf(1.0f + __builtin_amdgcn_exp2f(-1.4426950408889634f * g0[j])); v1[j] = v1[j] * __builtin_amdgcn_rcpf(1.0f + __builtin_amdgcn_exp2f(-1.4426950408889634f * g1[j])); }
                *(u32x2*)(MIX + (size_t)row * DM + 1024 + col) = pack8_fp8(v0, v1, MIX_SCALE); __builtin_amdgcn_sched_barrier(0); }
    }
};

struct EpiOut {
    static constexpr bool PERM = true, AFTER_DRAIN = false;
    const float* xp; const float* xs; bf16_t* H2; float* stat; const float* mod; const float* gffn;
    __device__ __forceinline__ void operator()(const f32x4 (&acc)[2][2][4][2], const Unit& u, int wr, int wc, int fr, int fq) const {
        const int row0 = u.pm * 256 + wr * 64 + fr, col0 = u.pn * 256 + wc * 32 + 8 * fq;
        const float* xb = u.pm < 128 ? xp : xs - (size_t)MP * DM;
#pragma unroll
        for (int ai = 0; ai < 2; ++ai) {
            const float* mp = mod + (size_t)batch_of_tile(u.pm, ai, wr) * MODW + col0;
            f32x4 gt[2][2], gs[2][2];
#pragma unroll
            for (int bj = 0; bj < 2; ++bj)
#pragma unroll
                for (int n = 0; n < 2; ++n) { gt[bj][n] = *(const f32x4*)(mp + 2 * DM + bj * 128 + 4 * n) * (1.0f / (MIX_SCALE * WOUT_SCALE));
                    gs[bj][n] = *(const f32x4*)(gffn + col0 + bj * 128 + 4 * n) * (*(const f32x4*)(mp + 4 * DM + bj * 128 + 4 * n) + 1.0f); }
#pragma unroll
            for (int m = 0; m < 4; ++m) { const int row = row0 + ai * 128 + m * 16; const size_t off = (size_t)row * DM + col0; float ss = 0.f;
#pragma unroll
                for (int bj = 0; bj < 2; ++bj) { const f32x4 a0 = *(const f32x4*)(xb + off + bj * 128) + gt[bj][0] * acc[ai][bj][m][0], a1 = *(const f32x4*)(xb + off + bj * 128 + 4) + gt[bj][1] * acc[ai][bj][m][1];
                    ss += (a0[0] * a0[0] + a0[1] * a0[1]) + (a0[2] * a0[2] + a0[3] * a0[3]) + (a1[0] * a1[0] + a1[1] * a1[1]) + (a1[2] * a1[2] + a1[3] * a1[3]);
                    *(u32x4*)(H2 + off + bj * 128) = pack8(a0 * gs[bj][0], a1 * gs[bj][1]); }
                ss += __shfl_xor(ss, 16); ss += __shfl_xor(ss, 32);
                if (fq == 0) stat[(size_t)row * 32 + u.pn * 4 + wc] = ss;
                asm volatile("" ::: "memory"); }
        }
    }
};

struct EpiFF1 {
    static constexpr bool PERM = true, AFTER_DRAIN = false;
    unsigned char* HID; const float* stat; const float* c2;
    __device__ __forceinline__ void operator()(const f32x4 (&acc)[2][2][4][2], const Unit& u, int wr, int wc, int fr, int fq) const {
        const int row0 = u.pm * 256 + wr * 64 + fr, col0 = u.pn * 256 + wc * 32 + 8 * fq;
#pragma unroll
        for (int ai = 0; ai < 2; ++ai) {
            const float* cp = c2 + (size_t)batch_of_tile(u.pm, ai, wr) * DFF + col0;
            f32x4 cv[2][2];
#pragma unroll
            for (int bj = 0; bj < 2; ++bj)
#pragma unroll
                for (int n = 0; n < 2; ++n) cv[bj][n] = *(const f32x4*)(cp + bj * 128 + 4 * n);
#pragma unroll
            for (int m = 0; m < 4; ++m) { const int row = row0 + ai * 128 + m * 16; unsigned char* rowp = HID + (size_t)row * DFF + col0;
                const f32x4 s0 = *(const f32x4*)(stat + (size_t)row * 32 + 8 * fq), s1 = *(const f32x4*)(stat + (size_t)row * 32 + 8 * fq + 4);
                float ss = ((s0[0] + s0[1]) + (s0[2] + s0[3])) + ((s1[0] + s1[1]) + (s1[2] + s1[3]));
                ss += __shfl_xor(ss, 16); ss += __shfl_xor(ss, 32);
                const float rs = (1.0f / sqrtf(ss * (1.0f / DM) + RMS_EPS)) * 2.8284271247461903f  ;
#pragma unroll
                for (int bj = 0; bj < 2; ++bj) { constexpr float CL = 21.166010488516726f  ;
                    f32x4 v0 = acc[ai][bj][m][0] * rs + cv[bj][0] * 2.8284271247461903f, v1 = acc[ai][bj][m][1] * rs + cv[bj][1] * 2.8284271247461903f;
#pragma unroll
                    for (int j = 0; j < 4; ++j) { v0[j] = __builtin_amdgcn_fmed3f(v0[j], 0.f, CL); v1[j] = __builtin_amdgcn_fmed3f(v1[j], 0.f, CL); }
                    v0 = v0 * v0; v1 = v1 * v1;
                    int w0 = __builtin_amdgcn_cvt_pk_fp8_f32(v0[0], v0[1], 0, false); w0 = __builtin_amdgcn_cvt_pk_fp8_f32(v0[2], v0[3], w0, true);
                    int w1 = __builtin_amdgcn_cvt_pk_fp8_f32(v1[0], v1[1], 0, false); w1 = __builtin_amdgcn_cvt_pk_fp8_f32(v1[2], v1[3], w1, true);
                    *(u32x2*)(rowp + bj * 128) = (u32x2){(unsigned)w0, (unsigned)w1}; } }
        }
    }
};

struct EpiFF2 {
    static constexpr bool PERM = true, AFTER_DRAIN = false;
    bf16_t* X2; const float* mod; float* slab; const bf16_t* H2; const float* gffn;
    __device__ __forceinline__ void operator()(const f32x4 (&acc)[2][2][4][2], const Unit& u, int wr, int wc, int fr, int fq) const {
        const int row0 = u.pm * 256 + wr * 64 + fr, col0 = u.pn * 256 + wc * 32 + 8 * fq;
        const int q = u.nk ? u.k0 / u.nk : 0;
#pragma unroll
        for (int ai = 0; ai < 2; ++ai) {
            const float* mp = mod + (size_t)batch_of_tile(u.pm, ai, wr) * MODW + col0;
            f32x4 gt[2][2], rg[2][2];
#pragma unroll
            for (int bj = 0; bj < 2; ++bj)
#pragma unroll
                for (int n = 0; n < 2; ++n) { gt[bj][n] = *(const f32x4*)(mp + 5 * DM + bj * 128 + 4 * n) * (1.0f / (HID_SCALE * W2_SCALE));
                    const f32x4 g = *(const f32x4*)(gffn + col0 + bj * 128 + 4 * n) * (*(const f32x4*)(mp + 4 * DM + bj * 128 + 4 * n) + 1.0f);
#pragma unroll
                    for (int j = 0; j < 4; ++j) rg[bj][n][j] = fabsf(g[j]) > 1e-20f ? 1.0f / g[j] : 0.f; }
#pragma unroll
            for (int m = 0; m < 4; ++m) { const size_t off = (size_t)(row0 + ai * 128 + m * 16) * DM + col0;
#pragma unroll
                for (int bj = 0; bj < 2; ++bj) {
                    const f32x4 p0 = gt[bj][0] * acc[ai][bj][m][0], p1 = gt[bj][1] * acc[ai][bj][m][1];
                    if (q != 0) { float* sp = slab + (size_t)q * ((size_t)MS * DM) + (off - (size_t)MP * DM) + bj * 128; *(f32x4*)sp = p0; *(f32x4*)(sp + 4) = p1; }
                    else { const u32x4 hw = *(const u32x4*)(H2 + off + bj * 128); f32x4 x0, x1;
                        x0[0] = __uint_as_float(hw[0] << 16); x0[1] = __uint_as_float(hw[0] & 0xffff0000u); x0[2] = __uint_as_float(hw[1] << 16); x0[3] = __uint_as_float(hw[1] & 0xffff0000u);
                        x1[0] = __uint_as_float(hw[2] << 16); x1[1] = __uint_as_float(hw[2] & 0xffff0000u); x1[2] = __uint_as_float(hw[3] << 16); x1[3] = __uint_as_float(hw[3] & 0xffff0000u);
                        *(u32x4*)(X2 + off + bj * 128) = pack8(x0 * rg[bj][0] + p0, x1 * rg[bj][1] + p1); } }
                asm volatile("" ::: "memory"); }
        }
    }
};

struct S5Order {
    int G, c;
    __device__ __forceinline__ bool next(int i, Unit& u) const { const int L = i * G + c; if (L >= SG * S5NT) return false; const int g = L / S5NT; u.pm = L; u.pn = g; u.k0 = 0; u.nk = 0; return true; }
    __device__ __forceinline__ void a_ready(const Unit&) const {}
    __device__ __forceinline__ void done(const Unit&) const {}
};
struct SplitTailOrder {
    pg8::StaticOrder full; int c, ntile;
    __device__ __forceinline__ void init(int N, int G_, int c_, int ntile_) { full.init(128 * 256, N, G_, c_); c = c_; ntile = ntile_; }
    __device__ __forceinline__ bool next(int i, Unit& u) const {
        if (full.next(i, u)) return true;
        if (i != full.nwg / full.G) return false;
        const int x = c & 7, j = c >> 3; u.pm = 128 + x; u.pn = j >> 2; u.k0 = (j & 3) * (ntile >> 2); u.nk = ntile >> 2; return true;
    }
    __device__ __forceinline__ void a_ready(const Unit&) const {}
    __device__ __forceinline__ void done(const Unit&) const {}
};
}

__device__ __forceinline__ float wave_sum(float v) {
#pragma unroll
    for (int o = 1; o < 64; o <<= 1) v += __shfl_xor(v, o);
    return v;
}
__device__ __forceinline__ double d_exp(double x) {
    const double k = __builtin_rint(x * 1.4426950408889634074);
    double r = __builtin_fma(-k, 6.93147180369123816490e-01, x); r = __builtin_fma(-k, 1.90821492927058770002e-10, r);
    double p = 1.0 / 6227020800.0;
    p = __builtin_fma(p, r, 1.0 / 479001600.0); p = __builtin_fma(p, r, 1.0 / 39916800.0); p = __builtin_fma(p, r, 1.0 / 3628800.0); p = __builtin_fma(p, r, 1.0 / 362880.0);
    p = __builtin_fma(p, r, 1.0 / 40320.0); p = __builtin_fma(p, r, 1.0 / 5040.0); p = __builtin_fma(p, r, 1.0 / 720.0); p = __builtin_fma(p, r, 1.0 / 120.0);
    p = __builtin_fma(p, r, 1.0 / 24.0); p = __builtin_fma(p, r, 1.0 / 6.0); p = __builtin_fma(p, r, 0.5); p = __builtin_fma(p, r, 1.0); p = __builtin_fma(p, r, 1.0);
    return ldexp(p, (int)k);
}
__device__ __forceinline__ void d_sincos(double x, double& s, double& c) {
    const double k = __builtin_rint(x * 0.63661977236758134308);
    double r = __builtin_fma(-k, 1.57079632673412561417e+00, x); r = __builtin_fma(-k, 6.07710050650619224932e-11, r);
    const double r2 = r * r;
    double ps = -1.0 / 1307674368000.0;
    ps = __builtin_fma(ps, r2, 1.0 / 6227020800.0); ps = __builtin_fma(ps, r2, -1.0 / 39916800.0); ps = __builtin_fma(ps, r2, 1.0 / 362880.0); ps = __builtin_fma(ps, r2, -1.0 / 5040.0);
    ps = __builtin_fma(ps, r2, 1.0 / 120.0); ps = __builtin_fma(ps, r2, -1.0 / 6.0); const double S = __builtin_fma(ps * r2, r, r);
    double pc = 1.0 / 20922789888000.0;
    pc = __builtin_fma(pc, r2, -1.0 / 87178291200.0); pc = __builtin_fma(pc, r2, 1.0 / 479001600.0); pc = __builtin_fma(pc, r2, -1.0 / 3628800.0); pc = __builtin_fma(pc, r2, 1.0 / 40320.0);
    pc = __builtin_fma(pc, r2, -1.0 / 720.0); pc = __builtin_fma(pc, r2, 1.0 / 24.0); pc = __builtin_fma(pc, r2, -0.5); const double C = __builtin_fma(pc, r2, 1.0);
    const int q = ((int)k) & 3;
    s = (q == 0) ? S : (q == 1) ? C : (q == 2) ? -S : -C;
    c = (q == 0) ? C : (q == 1) ? -S : (q == 2) ? -C : S;
}

struct Args { const float* in[32]; float* out; unsigned char* ws; };
typedef const __attribute__((address_space(4))) Args* KA;

__device__ __forceinline__ void p0_transpose_item(const float* W, int K, int N, bf16* WT, int wrow0, LAS float* scr, int k0, int n0, int lane) {
    float tv[32];
#pragma unroll
    for (int i = 0; i < 32; ++i) { const int kk = 2 * i + (lane >> 5); tv[i] = W[(size_t)(k0 + kk) * N + n0 + (lane & 31)]; }
#pragma unroll
    for (int i = 0; i < 32; ++i) { const int kk = 2 * i + (lane >> 5); scr[kk * 33 + (lane & 31)] = tv[i]; }
    LDS_WAIT(); asm volatile("" ::: "memory");
    const int c = lane & 7;
#pragma unroll
    for (int j = 0; j < 4; ++j) { const int n = (lane >> 3) + 8 * j; const LAS float* s = scr + (8 * c) * 33 + n;
        v4u o; o.x = pk2(s[0 * 33], s[1 * 33]); o.y = pk2(s[2 * 33], s[3 * 33]); o.z = pk2(s[4 * 33], s[5 * 33]); o.w = pk2(s[6 * 33], s[7 * 33]);
        *(GAS v4u*)(WT + (size_t)(wrow0 + n) * K + k0 + 8 * c) = o; }
    LDS_WAIT(); asm volatile("" ::: "memory");
}

__device__ __forceinline__ void p0_transpose_item8(const float* W, int K, int N, unsigned char* WT, int wrow0, LAS float* scr, int k0, int n0, int lane, float scale) {
    float tv[32];
#pragma unroll
    for (int i = 0; i < 32; ++i) { const int kk = 2 * i + (lane >> 5); tv[i] = W[(size_t)(k0 + kk) * N + n0 + (lane & 31)]; }
#pragma unroll
    for (int i = 0; i < 32; ++i) { const int kk = 2 * i + (lane >> 5); scr[kk * 33 + (lane & 31)] = tv[i]; }
    LDS_WAIT(); asm volatile("" ::: "memory");
    const int c = lane & 3;
#pragma unroll
    for (int j = 0; j < 2; ++j) { const int n = (lane >> 2) + 16 * j; const LAS float* s = scr + (16 * c) * 33 + n; v4u o;
#pragma unroll
        for (int w = 0; w < 4; ++w) { int x = __builtin_amdgcn_cvt_pk_fp8_f32(s[(4 * w + 0) * 33] * scale, s[(4 * w + 1) * 33] * scale, 0, false); x = __builtin_amdgcn_cvt_pk_fp8_f32(s[(4 * w + 2) * 33] * scale, s[(4 * w + 3) * 33] * scale, x, true); o[w] = (unsigned)x; }
        *(GAS v4u*)(WT + (size_t)(wrow0 + n) * K + k0 + 16 * c) = o; }
    LDS_WAIT(); asm volatile("" ::: "memory");
}

template <int MODE> __device__ __forceinline__ void skinny36_item(KA a, int it, LAS unsigned char* lds, int tid, int wave, int lane, const float* MODr, float* outp) {
    LAS float* S = (LAS float*)lds;
    const float* W = a->in[MODE == 0 ? I_WADA : I_WFF1]; const float* cp = a->in[I_CP]; const float* cs = a->in[I_CS];
    constexpr int LDW = MODE == 0 ? MODW : DFF, NPASS = MODE == 0 ? 4 : 2;
    const int n0 = (MODE == 0 ? it : (it >> 1)) * 64, kbase = MODE == 0 ? 0 : (it & 1) * 1024;
    float acc[36];
#pragma unroll
    for (int i = 0; i < 36; ++i) acc[i] = 0.f;
    for (int q = 0; q < NPASS; ++q) {
        __syncthreads();
        unsigned toff = (unsigned)tid * 4u; asm volatile("" : "+v"(toff));
#pragma unroll 4
        for (int bb = 0; bb < 36; ++bb) { float sv;
            if (MODE == 0) { const float* rp = bb < 4 ? cp + bb * DM + q * 512 : cs + (bb - 4) * DM + q * 512; const float c = *(const float*)((const char*)rp + toff); sv = c / (1.0f + __expf(-c)); }
            else { const float* rp = MODr + (size_t)bb * MODW + 3 * DM + kbase + q * 512; sv = *(const float*)((const char*)rp + toff); }
            S[tid * 36 + bb] = sv; }
        __syncthreads();
        const float* wp = W + (size_t)(kbase + q * 512 + wave * 64) * LDW + n0 + lane;
#pragma unroll 1
        for (int kk0 = 0; kk0 < 64; kk0 += 16) {
            float wv[16];
#pragma unroll
            for (int x = 0; x < 16; ++x) wv[x] = wp[(size_t)(kk0 + x) * LDW];
#pragma unroll
            for (int x = 0; x < 16; ++x) { const LAS f32x4* sp = (const LAS f32x4*)(S + (wave * 64 + kk0 + x) * 36);
#pragma unroll
                for (int q4 = 0; q4 < 9; ++q4) { const f32x4 s4 = sp[q4]; acc[4 * q4 + 0] += s4.x * wv[x]; acc[4 * q4 + 1] += s4.y * wv[x]; acc[4 * q4 + 2] += s4.z * wv[x]; acc[4 * q4 + 3] += s4.w * wv[x]; } }
        }
    }
    __syncthreads();
    LAS float* R = (LAS float*)lds;
#pragma unroll
    for (int bb = 0; bb < 36; ++bb) R[(wave * 36 + bb) * 64 + lane] = acc[bb];
    __syncthreads();
    for (int o = tid; o < 36 * 64; o += 512) { const int bb = o >> 6, ln = o & 63; float s = MODE == 0 ? a->in[I_BADA][n0 + ln] : 0.f;
#pragma unroll
        for (int w = 0; w < 8; ++w) s += R[(w * 36 + bb) * 64 + ln];
        if (MODE == 0) outp[(size_t)bb * MODW + n0 + ln] = s; else outp[((size_t)(it & 1) * NMOD + bb) * DFF + n0 + ln] = s; }
    __syncthreads();
}

__device__ __forceinline__ void c2_mfma_item(int blk, const bf16* SHB, const bf16* W1T, float* C2, LAS unsigned char* lds, int wave, int lane) {
    typedef float f32x16_ __attribute__((ext_vector_type(16)));
    const int r32 = lane & 31, hi = lane >> 5, n0 = blk * 32;
    const bf16* ap = SHB + (size_t)r32 * DM + wave * 256 + hi * 8; const bf16* bp = W1T + (size_t)(n0 + r32) * DM + wave * 256 + hi * 8;
    f32x16_ c0 = {}, c1 = {};
#pragma unroll 4
    for (int ks = 0; ks < 16; ++ks) {
        const bf16x8 a0 = *(const bf16x8*)(ap + ks * 16), a1 = *(const bf16x8*)(ap + 32 * DM + ks * 16), b = *(const bf16x8*)(bp + ks * 16);
        c0 = __builtin_amdgcn_mfma_f32_32x32x16_bf16(a0, b, c0, 0, 0, 0); c1 = __builtin_amdgcn_mfma_f32_32x32x16_bf16(a1, b, c1, 0, 0, 0);
    }
    LAS float* R = (LAS float*)lds;
    __syncthreads();
#pragma unroll
    for (int r = 0; r < 16; ++r) { const int row = (r & 3) + 8 * (r >> 2) + 4 * hi; R[(wave * 36 + row) * 32 + r32] = c0[r]; if (row < 4) R[(wave * 36 + 32 + row) * 32 + r32] = c1[r]; }
    __syncthreads();
    for (int o = (int)threadIdx.x; o < 36 * 32; o += 512) { const int row = o >> 5, col = o & 31; float s = 0.f;
#pragma unroll
        for (int w = 0; w < 8; ++w) s += R[(w * 36 + row) * 32 + col];
        C2[(size_t)row * DFF + n0 + col] = s; }
    __syncthreads();
}

__device__ __forceinline__ void s5_gen_group(KA a, int g, LAS unsigned char* lds, int tid, bf16* BTM, bf16* BTE, float* A16) {
    LAS float* APOW = (LAS float*)lds;
    LAS float* BB = APOW + 17 * 64 * 2;
    LAS float* CC = BB + 64 * 16 * 2;
    LAS float* KM = CC + 16 * 64 * 2;
    __syncthreads();
    if (tid < 64) {
        const int p = tid;
        const double dt = d_exp((double)a->in[I_LDT][g]);
        const double lre = (double)a->in[I_LRE][g * SP + p], lim = (double)a->in[I_LIM][g * SP + p];
        double a1r = 1.0, a1i = 0.0;
        for (int m = 0; m <= 16; ++m) {
            const double mag = d_exp(lre * dt * (double)m); double sn, cs; d_sincos(lim * dt * (double)m, sn, cs);
            const double ar = mag * cs, ai = mag * sn;
            APOW[(m * 64 + p) * 2 + 0] = (float)ar; APOW[(m * 64 + p) * 2 + 1] = (float)ai;
            if (m == 1) { a1r = ar; a1i = ai; }
            if (m == 16) { A16[(g * SP + p) * 2 + 0] = (float)ar; A16[(g * SP + p) * 2 + 1] = (float)ai; }
        }
        const double den = lre * lre + lim * lim;
        const double fre = ((a1r - 1.0) * lre + a1i * lim) / den, fim = (a1i * lre - (a1r - 1.0) * lim) / den;
        for (int h = 0; h < SH; ++h) {
            const double br = (double)a->in[I_BRE][(g * SP + p) * SH + h], bi = (double)a->in[I_BIM][(g * SP + p) * SH + h];
            BB[(p * 16 + h) * 2 + 0] = (float)(fre * br - fim * bi); BB[(p * 16 + h) * 2 + 1] = (float)(fre * bi + fim * br);
        }
    }
    for (int e = tid; e < SH * SP; e += 512) { CC[e * 2 + 0] = a->in[I_CRE][g * SH * SP + e]; CC[e * 2 + 1] = a->in[I_CIM][g * SH * SP + e]; }
    __syncthreads();
    for (int e = tid; e < 16 * 16 * 16; e += 512) {
        const int m = e >> 8, h = (e >> 4) & 15, h2 = e & 15; float s = 0.f;
        for (int p = 0; p < SP; ++p) {
            const float cr = CC[(h * 64 + p) * 2], ci = CC[(h * 64 + p) * 2 + 1], ar = APOW[(m * 64 + p) * 2], ai = APOW[(m * 64 + p) * 2 + 1];
            const float wr = cr * ar - ci * ai, wi = cr * ai + ci * ar;
            s += wr * BB[(p * 16 + h2) * 2] - wi * BB[(p * 16 + h2) * 2 + 1];
        }
        if (m == 0 && h == h2) s += a->in[I_SD][g * SH + h];
        KM[e] = s;
    }
    __syncthreads();
    for (int q = tid; q < 256 * 48; q += 512) {
        const int n = q / 48, kp = q - n * 48, t = n >> 4, h = n & 15; float v[8];
        if (kp < 32) { const int j = kp >> 1, h0 = (kp & 1) * 8;
#pragma unroll
            for (int x = 0; x < 8; ++x) v[x] = (t >= j) ? KM[((t - j) * 16 + h) * 16 + h0 + x] : 0.f;
        } else { const int kk0 = (kp - 32) * 8, p0 = kk0 & 63, im = kk0 >> 6;
#pragma unroll
            for (int x = 0; x < 8; ++x) { const int p = p0 + x; const float cr = CC[(h * 64 + p) * 2], ci = CC[(h * 64 + p) * 2 + 1], ar = APOW[((t + 1) * 64 + p) * 2], ai = APOW[((t + 1) * 64 + p) * 2 + 1];
                v[x] = im ? (-cr * ai - ci * ar) : (cr * ar - ci * ai); }
        }
        v4u o; o.x = pk2(v[0], v[1]); o.y = pk2(v[2], v[3]); o.z = pk2(v[4], v[5]); o.w = pk2(v[6], v[7]);
        *(GAS v4u*)(BTM + ((size_t)g * 256 + n) * S5K + 8 * kp) = o;
    }
    for (int q = tid; q < 128 * 32; q += 512) {
        const int n = q >> 5, kp = q & 31, j = kp >> 1, h0 = (kp & 1) * 8, p = n & 63, im = n >> 6; float v[8];
        const float ar = APOW[((15 - j) * 64 + p) * 2], ai = APOW[((15 - j) * 64 + p) * 2 + 1];
#pragma unroll
        for (int x = 0; x < 8; ++x) { const float br = BB[(p * 16 + h0 + x) * 2], bi = BB[(p * 16 + h0 + x) * 2 + 1]; v[x] = im ? (ar * bi + ai * br) : (ar * br - ai * bi); }
        v4u o; o.x = pk2(v[0], v[1]); o.y = pk2(v[2], v[3]); o.z = pk2(v[4], v[5]); o.w = pk2(v[6], v[7]);
        *(GAS v4u*)(BTE + ((size_t)g * 256 + n) * 256 + 8 * kp) = o;
    }
    __syncthreads();
}

__device__ __forceinline__ int batch_of_row(int r) { return r < MP ? (r >> 13) : 4 + ((r - MP) >> 6); }
template <int WHICH> __device__ __forceinline__ void norm_mod_pass(KA a, const float* MOD, const float* Y, float* Yw, bf16* H, int gw, int ngw, int lane) {
    const int per = (M + ngw - 1) / ngw, r0 = gw * per, r1 = (r0 + per < M) ? r0 + per : M;
    const float* gvec = a->in[WHICH == 0 ? I_GMIX : I_GFFN]; const float* xp = a->in[I_XP]; const float* xs = a->in[I_XS];
    const int sh_chunk = WHICH == 0 ? 0 : 3, sc_chunk = WHICH == 0 ? 1 : 4;
    int cur_b = -1; f32x4 gs[8], sh[8], v[8], vn[8];
#pragma unroll
    for (int j = 0; j < 8; ++j) { gs[j] = (f32x4){0.f, 0.f, 0.f, 0.f}; sh[j] = gs[j]; vn[j] = gs[j]; }
#define ROWSRC(r) (WHICH == 0 ? ((r) < MP ? xp + (size_t)(r) * DM : xs + (size_t)((r) - MP) * DM) : Y + (size_t)(r) * DM)
    if (r0 < r1) { const float* s0 = ROWSRC(r0);
#pragma unroll
        for (int j = 0; j < 8; ++j) vn[j] = *(const f32x4*)(s0 + 4 * lane + 256 * j); }
    for (int r = r0; r < r1; ++r) {
#pragma unroll
        for (int j = 0; j < 8; ++j) v[j] = vn[j];
        if (r + 1 < r1) { const float* s1 = ROWSRC(r + 1);
#pragma unroll
            for (int j = 0; j < 8; ++j) vn[j] = *(const f32x4*)(s1 + 4 * lane + 256 * j); }
        const int b = batch_of_row(r);
        if (b != cur_b) { cur_b = b; const float* mp = MOD + (size_t)b * MODW;
#pragma unroll
            for (int j = 0; j < 8; ++j) { const int k = 4 * lane + 256 * j; const f32x4 g4 = *(const f32x4*)(gvec + k), s4 = *(const f32x4*)(mp + sc_chunk * DM + k); gs[j] = g4 * (s4 + 1.0f); sh[j] = *(const f32x4*)(mp + sh_chunk * DM + k); } }
        float ss = 0.f;
#pragma unroll
        for (int j = 0; j < 8; ++j) ss += (v[j].x * v[j].x + v[j].y * v[j].y) + (v[j].z * v[j].z + v[j].w * v[j].w);
        const float rstd = 1.0f / sqrtf(wave_sum(ss) * (1.0f / DM) + RMS_EPS);
        bf16* dst = H + (size_t)r * DM + 4 * lane;
#pragma unroll
        for (int j = 0; j < 8; ++j) { const f32x4 h = v[j] * rstd * gs[j] + sh[j];
            *(GAS unsigned long long*)(dst + 256 * j) = (unsigned long long)pk2(h.x, h.y) | ((unsigned long long)pk2(h.z, h.w) << 32); }
    }
#undef ROWSRC
    (void)Yw;
}
__device__ __forceinline__ void final_norm_pass(KA a, float* Y, const bf16* X2, const float* slab, int gw, int ngw, int lane) {
    typedef unsigned u32x2_ __attribute__((ext_vector_type(2)));
    const float* gvec = a->in[I_GFIN]; f32x4 g4[8], v[8]; u32x2_ vn[8];
#pragma unroll
    for (int j = 0; j < 8; ++j) { g4[j] = *(const f32x4*)(gvec + 4 * lane + 256 * j); vn[j] = (u32x2_){0u, 0u}; }
    if (gw < M) { const bf16* s0 = X2 + (size_t)gw * DM + 4 * lane;
#pragma unroll
        for (int j = 0; j < 8; ++j) vn[j] = *(const u32x2_*)(s0 + 256 * j); }
    for (int r = gw; r < M; r += ngw) {
        float* row = Y + (size_t)r * DM + 4 * lane; float ss = 0.f;
#pragma unroll
        for (int j = 0; j < 8; ++j) v[j] = (f32x4){__uint_as_float(vn[j].x << 16), __uint_as_float(vn[j].x & 0xffff0000u), __uint_as_float(vn[j].y << 16), __uint_as_float(vn[j].y & 0xffff0000u)};
        if (r + ngw < M) { const bf16* s1 = X2 + (size_t)(r + ngw) * DM + 4 * lane;
#pragma unroll
            for (int j = 0; j < 8; ++j) vn[j] = *(const u32x2_*)(s1 + 256 * j); }
        if (slab && r >= MP) { const float* sp = slab + (size_t)(r - MP) * DM + 4 * lane;
#pragma unroll
            for (int q = 1; q < 4; ++q)
#pragma unroll
                for (int j = 0; j < 8; ++j) v[j] = v[j] + *(const f32x4*)(sp + (size_t)q * MS * DM + 256 * j); }
#pragma unroll
        for (int j = 0; j < 8; ++j) ss += (v[j].x * v[j].x + v[j].y * v[j].y) + (v[j].z * v[j].z + v[j].w * v[j].w);
        const float rstd = 1.0f / sqrtf(wave_sum(ss) * (1.0f / DM) + RMS_EPS);
#pragma unroll
        for (int j = 0; j < 8; ++j) *(f32x4*)(row + 256 * j) = v[j] * rstd * g4[j];
    }
}

template <int NSTEP, bool STORE> __device__ __forceinline__ void carry_steps(const float* __restrict__ Eg, bf16* __restrict__ Ug, int row0, int p, float a16r, float a16i, float& hr, float& hi) {
    float er[NSTEP], ei[NSTEP];
#pragma unroll
    for (int k = 0; k < NSTEP; ++k) { er[k] = Eg[(size_t)(row0 + k) * 128 + p]; ei[k] = Eg[(size_t)(row0 + k) * 128 + 64 + p]; }
#pragma unroll
    for (int k = 0; k < NSTEP; ++k) {
        if (STORE) { bf16* u = Ug + (size_t)(row0 + k) * S5K + 256 + p; u[0] = (bf16)f2bf(hr); u[64] = (bf16)f2bf(hi); }
        const float nr = a16r * hr - a16i * hi + er[k], ni = a16r * hi + a16i * hr + ei[k]; hr = nr; hi = ni;
    }
}
__device__ __forceinline__ void carry_scan(KA a, const float* E, bf16* Ur, const float* A16, float* out, LAS unsigned char* lds, int vcu, int G, int wave, int lane) {
    const int p = lane;
    for (int s = vcu * NWAVES + wave; s < NBS * SG; s += G * NWAVES) {
        const int bs = s >> 6, g = s & 63; const float a16r = A16[(g * SP + p) * 2], a16i = A16[(g * SP + p) * 2 + 1];
        float hr = a->in[I_SRE][(bs * SG + g) * SP + p], hi = a->in[I_SIM][(bs * SG + g) * SP + p];
        carry_steps<4, true>(E + (size_t)g * NROW * 128, Ur + (size_t)g * NROWP * S5K, MP / TS + bs * 4, p, a16r, a16i, hr, hi);
        out[O_SRS + (bs * SG + g) * SP + p] = hr; out[O_SIS + (bs * SG + g) * SP + p] = hi;
    }
    LAS float* SEGL = (LAS float*)lds;
    for (int l = vcu; l < NBP * SG; l += G) {
        const int b = l >> 6, g = l & 63, seg = wave; const float a16r = A16[(g * SP + p) * 2], a16i = A16[(g * SP + p) * 2 + 1];
        const float* Eg = E + (size_t)g * NROW * 128; bf16* Ug = Ur + (size_t)g * NROWP * S5K; const int row0 = b * (SEQ / TS) + seg * 64;
        float hr = 0.f, hi = 0.f;
#pragma unroll 1
        for (int k0 = 0; k0 < 64; k0 += 16) carry_steps<16, false>(Eg, Ug, row0 + k0, p, a16r, a16i, hr, hi);
        __syncthreads();
        SEGL[(seg * 64 + p) * 2] = hr; SEGL[(seg * 64 + p) * 2 + 1] = hi;
        __syncthreads();
        float pr = a16r, pi = a16i;
#pragma unroll
        for (int q = 0; q < 6; ++q) { const float nr = pr * pr - pi * pi, ni = 2.f * pr * pi; pr = nr; pi = ni; }
        hr = 0.f; hi = 0.f;
        for (int s2 = 0; s2 < seg; ++s2) { const float lr = SEGL[(s2 * 64 + p) * 2], li = SEGL[(s2 * 64 + p) * 2 + 1]; const float nr = pr * hr - pi * hi + lr, ni = pr * hi + pi * hr + li; hr = nr; hi = ni; }
#pragma unroll 1
        for (int k0 = 0; k0 < 64; k0 += 16) carry_steps<16, true>(Eg, Ug, row0 + k0, p, a16r, a16i, hr, hi);
        if (seg == 7) { out[O_SRP + (b * SG + g) * SP + p] = hr; out[O_SIP + (b * SG + g) * SP + p] = hi; }
    }
}

namespace att {
using f32x16 = __attribute__((ext_vector_type(16))) float;
using f32x8  = __attribute__((ext_vector_type(8))) float;
using v4i    = __attribute__((ext_vector_type(4))) int;
using v8i    = __attribute__((ext_vector_type(8))) int;
typedef float f32x2 __attribute__((ext_vector_type(2)));
constexpr int KVBLK = 64;
constexpr float SCALE = 0.125f;
constexpr float SQ = epi::ATT_SQ, SK = epi::ATT_SK, SP = epi::ATT_SP, SV = epi::ATT_SV;
constexpr float CS = SCALE * 1.4426950408889634f / (SQ * SK);
constexpr float THR_RAW = 4.0f / CS;
constexpr int KPITCH = 144, VPITCH = 80;
constexpr int SHM_K = KVBLK * KPITCH, SHM_V = 128 * VPITCH, SHM_BUF = SHM_K + SHM_V;
constexpr int NBUF = 4;
constexpr int OFF_BUF = 0, OFF_WS = NBUF * SHM_BUF, OFF_XCH = 0  , ATT_LDS = OFF_WS + NWAVES * 64 * 4;
static_assert(4 * 16384 <= OFF_WS, "exchange fits in the ring");
static_assert(ATT_LDS <= RING_BYTES && OFF_WS % 16 == 0 && SHM_BUF % 16 == 0 && SHM_K % 16 == 0, "attention LDS");
#define SBAR() __builtin_amdgcn_sched_barrier(0)
__device__ __forceinline__ int crow(int r, int hi) { return (r & 3) + 8 * (r >> 2) + 4 * hi; }
__device__ __forceinline__ int pk4_fp8(float a, float b, float c, float d) { int w = __builtin_amdgcn_cvt_pk_fp8_f32(a, b, 0, false); return __builtin_amdgcn_cvt_pk_fp8_f32(c, d, w, true); }
using epi::vpos;

template <bool PROMPT, int SDEPTH, bool LAG>
__device__ __forceinline__ void attn_unit(const unsigned char* Qw, const void* Kh, const void* Vh, const void* Kn, const void* Vn, int ncache, int NT,
                                          bool active, int c, int rb, int limit, float lam, const float* gsub, unsigned char* Ow, char* lds) {
  int tid = threadIdx.x; asm volatile("" : "+v"(tid));
  const int wid = __builtin_amdgcn_readfirstlane(tid >> 6), lane = tid & 63, r32 = lane & 31, hi = lane >> 5;
  char* B_lds = lds + OFF_BUF;
  float* ws = (float*)(lds + OFF_WS) + wid * 64; float* li_l = ws; float* al_l = ws + 32;
  float m_reg = -1e30f, l_reg = 0; f32x16 o[4] = {}; v8i qf = {};
  if (active) { const v4i* ql = (const v4i*)(Qw + (long)r32 * 1024 + hi * 32); const v4i q0 = ql[0], q1 = ql[1]; qf = __builtin_shufflevector(q0, q1, 0, 1, 2, 3, 4, 5, 6, 7); }
  struct SP_ { v4i ks, vs; }; struct SS_ { f32x8 ks0, ks1, vs0, vs1; };
  typename std::conditional<PROMPT, SP_, SS_>::type sr_[SDEPTH];
  unsigned gk0, gv0, lk0, lv0;
  if constexpr (PROMPT) { gk0 = (unsigned)((tid >> 3) * 1024 + (tid & 7) * 16); lk0 = (unsigned)((tid >> 3) * KPITCH + (tid & 7) * 16); gv0 = (unsigned)(tid * 16); lv0 = (unsigned)(SHM_K + (tid >> 2) * VPITCH + (tid & 3) * 16); }
  else { const int sr = tid >> 4, sc = (tid & 15) * 8; gk0 = (unsigned)((sr * 1024 + sc) * 4); gv0 = 0;
         lk0 = (unsigned)(sr * KPITCH + sc); lv0 = (unsigned)(SHM_K + sc * VPITCH + vpos(sr)); }
  asm volatile("" : "+v"(gk0), "+v"(gv0));
#define SLOAD(i, t) do { const int t_ = (t); \
    if constexpr (PROMPT) { const char* kp_ = (const char*)Kh + (long)t_ * (KVBLK * 1024); const char* vp_ = (const char*)Vh + (long)t_ * 8192; \
        sr_[i].ks = *reinterpret_cast<const v4i*>(kp_ + gk0); sr_[i].vs = *reinterpret_cast<const v4i*>(vp_ + gv0); } \
    else { const char* kp_ = t_ < ncache ? (const char*)Kh + (long)t_ * (KVBLK * 1024 * 4) : (const char*)Kn; const char* vp_ = t_ < ncache ? (const char*)Vh + (long)t_ * (KVBLK * 1024 * 4) : (const char*)Vn; \
        sr_[i].ks0 = *reinterpret_cast<const f32x8*>(kp_ + gk0); sr_[i].ks1 = *reinterpret_cast<const f32x8*>(kp_ + 32 * 1024 * 4 + gk0); sr_[i].vs0 = *reinterpret_cast<const f32x8*>(vp_ + gk0); sr_[i].vs1 = *reinterpret_cast<const f32x8*>(vp_ + 32 * 1024 * 4 + gk0); } } while (0)
#define CV8(x, s) { pk4_fp8(x[0] * s, x[1] * s, x[2] * s, x[3] * s), pk4_fp8(x[4] * s, x[5] * s, x[6] * s, x[7] * s) }
#define SWRITE(b, i) do { char* bb_ = B_lds + (b) * SHM_BUF; \
    if constexpr (PROMPT) { *reinterpret_cast<v4i*>(bb_ + lk0) = sr_[i].ks; *reinterpret_cast<v4i*>(bb_ + lv0) = sr_[i].vs; } \
    else { const int ka_[2] = CV8(sr_[i].ks0, SK), kb_[2] = CV8(sr_[i].ks1, SK); const int va_[2] = CV8(sr_[i].vs0, SV), vb_[2] = CV8(sr_[i].vs1, SV); \
        *reinterpret_cast<unsigned long long*>(bb_ + lk0) = (unsigned long long)(unsigned)ka_[0] | ((unsigned long long)(unsigned)ka_[1] << 32); \
        *reinterpret_cast<unsigned long long*>(bb_ + lk0 + 32 * KPITCH) = (unsigned long long)(unsigned)kb_[0] | ((unsigned long long)(unsigned)kb_[1] << 32); \
        _Pragma("unroll") for (int x_ = 0; x_ < 8; ++x_) { *reinterpret_cast<unsigned char*>(bb_ + lv0 + x_ * VPITCH) = (unsigned char)((unsigned)va_[x_ >> 2] >> (8 * (x_ & 3))); \
                                                           *reinterpret_cast<unsigned char*>(bb_ + lv0 + 16 + x_ * VPITCH) = (unsigned char)((unsigned)vb_[x_ >> 2] >> (8 * (x_ & 3))); } } } while (0)
#define SWAIT() do { if constexpr (SDEPTH == 2) asm volatile("s_waitcnt vmcnt(2)" ::: "memory"); else asm volatile("s_waitcnt vmcnt(0)" ::: "memory"); } while (0)
#define ONOPS() asm volatile("s_nop 15\n\ts_nop 15" ::: "memory")
#define RESC(a) do { if (__any((a) < 1.f)) { if (hi == 0) al_l[r32] = (a); asm volatile("s_waitcnt lgkmcnt(0)" ::: "memory"); SBAR(); ONOPS(); SBAR(); \
    _Pragma("unroll") for (int d = 0; d < 4; ++d) _Pragma("unroll") for (int r = 0; r < 16; ++r) o[d][r] *= al_l[crow(r, hi)]; SBAR(); asm volatile("s_nop 1" ::: "memory"); SBAR(); } } while (0)
  const char* Kr = B_lds + r32 * KPITCH + c * 64 + hi * 32;
  const char* Vr = B_lds + SHM_K + r32 * VPITCH + hi * 32;
#define LD8(p) ({ const v4i a_ = *reinterpret_cast<const v4i*>(p), b_ = *reinterpret_cast<const v4i*>((p) + 16); (v8i)__builtin_shufflevector(a_, b_, 0, 1, 2, 3, 4, 5, 6, 7); })
#define MFQK(Kf) __builtin_amdgcn_mfma_scale_f32_32x32x64_f8f6f4(Kf, qf, (f32x16){}, 0, 0, 0, 0, 0, 0)
#define MFPV(D0, Vf) asm volatile("s_nop 1\n\tv_mfma_f32_32x32x64_f8f6f4 %0, %1, %2, %0" : "+v"(o[D0]) : "v"(p8), "v"(Vf))
#define EX2(x) do { unsigned u_; asm("v_cvt_u32_f32 %0, %1" : "=v"(u_) : "v"(x)); x = __uint_as_float(u_); } while (0)
#define MX3(a, b, cc) __builtin_fmaxf(__builtin_fmaxf((a), (b)), (cc))
#define FM2(P, R) do { f32x2 t_ = {P[R], P[R + 1]}; t_ = __builtin_elementwise_fma(t_, c2_, m2_); P[R] = t_.x; P[R + 1] = t_.y; } while (0)
#define PHASE_A(N0, N1, O0, O1, alO, Kb) do { const char* kb_ = (Kb); f32x2 s2_; \
    SBAR(); const v8i k0_ = LD8(kb_), k1_ = LD8(kb_ + 32 * KPITCH); SBAR(); \
    N0 = MFQK(k0_); EX2(O1[8]); EX2(O1[9]); EX2(O1[10]); EX2(O1[11]); EX2(O1[12]); EX2(O1[13]); EX2(O1[14]); EX2(O1[15]); \
        p8[0] = pk4_fp8(O0[0] * SP, O0[1] * SP, O0[2] * SP, O0[3] * SP); p8[1] = pk4_fp8(O0[4] * SP, O0[5] * SP, O0[6] * SP, O0[7] * SP); \
        p8[2] = pk4_fp8(O0[8] * SP, O0[9] * SP, O0[10] * SP, O0[11] * SP); p8[3] = pk4_fp8(O0[12] * SP, O0[13] * SP, O0[14] * SP, O0[15] * SP); SBAR(); \
    N1 = MFQK(k1_); s2_ = (f32x2){O0[0], O0[1]}; _Pragma("unroll") for (int r_ = 2; r_ < 16; r_ += 2) s2_ += (f32x2){O0[r_], O0[r_ + 1]}; \
        _Pragma("unroll") for (int r_ = 0; r_ < 16; r_ += 2) s2_ += (f32x2){O1[r_], O1[r_ + 1]}; \
        { float ps_ = s2_.x + s2_.y; auto rr_ = __builtin_amdgcn_permlane32_swap(__float_as_uint(ps_), __float_as_uint(ps_), false, false); \
          ps_ = __uint_as_float(rr_[0]) + __uint_as_float(rr_[1]); l_reg = l_reg * (alO) + ps_; } \
        p8[4] = pk4_fp8(O1[0] * SP, O1[1] * SP, O1[2] * SP, O1[3] * SP); p8[5] = pk4_fp8(O1[4] * SP, O1[5] * SP, O1[6] * SP, O1[7] * SP); \
        p8[6] = pk4_fp8(O1[8] * SP, O1[9] * SP, O1[10] * SP, O1[11] * SP); p8[7] = pk4_fp8(O1[12] * SP, O1[13] * SP, O1[14] * SP, O1[15] * SP); SBAR(); } while (0)
#define PHASE_B(N0, N1, mnN, alN, Vb, tN) do { const char* vb_ = (Vb); const bool msk_ = (tN) >= limit; float ma_, mb_; f32x2 c2_, m2_; \
    SBAR(); const v8i v0_ = LD8(vb_), v1_ = LD8(vb_ + 32 * VPITCH); SBAR(); \
    MFPV(0, v0_); const v8i v2_ = LD8(vb_ + 64 * VPITCH); ma_ = MX3(N0[0], N0[1], N0[2]); mb_ = MX3(N1[0], N1[1], N1[2]); \
        _Pragma("unroll") for (int r_ = 3; r_ < 15; r_ += 2) { ma_ = MX3(ma_, N0[r_], N0[r_ + 1]); mb_ = MX3(mb_, N1[r_], N1[r_ + 1]); } ma_ = MX3(ma_, N0[15], N1[15]); ma_ = __builtin_fmaxf(ma_, mb_); \
        { auto rr_ = __builtin_amdgcn_permlane32_swap(__float_as_uint(ma_), __float_as_uint(ma_), false, false); ma_ = __builtin_fmaxf(__uint_as_float(rr_[0]), __uint_as_float(rr_[1])); } \
        ma_ = msk_ ? -1e30f : ma_; { const bool keep_ = __all(ma_ - m_reg <= THR_RAW); mnN = keep_ ? m_reg : __builtin_fmaxf(m_reg, ma_); } alN = __builtin_amdgcn_exp2f((m_reg - mnN) * CS); m_reg = mnN; \
        { const float ce_ = msk_ ? 0.f : CS * 8388608.0f, mc_ = msk_ ? -1e30f : (126.955f - mnN * CS) * 8388608.0f; c2_ = (f32x2){ce_, ce_}; m2_ = (f32x2){mc_, mc_}; } SBAR(); \
    MFPV(1, v1_); const v8i v3_ = LD8(vb_ + 96 * VPITCH); _Pragma("unroll") for (int r_ = 0; r_ < 16; r_ += 2) { FM2(N0, r_); FM2(N1, r_); } \
        EX2(N0[0]); EX2(N0[1]); EX2(N0[2]); EX2(N0[3]); SBAR(); \
    MFPV(2, v2_); _Pragma("unroll") for (int r_ = 4; r_ < 14; ++r_) EX2(N0[r_]); SBAR(); \
    MFPV(3, v3_); EX2(N0[14]); EX2(N0[15]); _Pragma("unroll") for (int r_ = 0; r_ < 8; ++r_) EX2(N1[r_]); SBAR(); } while (0)
#define SOFT_FIRST(N0, N1, mnN, alN, tN) do { const bool msk_ = (tN) >= limit; float ma_ = N0[0]; f32x2 c2_, m2_; \
    _Pragma("unroll") for (int r_ = 1; r_ < 16; ++r_) ma_ = __builtin_fmaxf(ma_, N0[r_]); _Pragma("unroll") for (int r_ = 0; r_ < 16; ++r_) ma_ = __builtin_fmaxf(ma_, N1[r_]); \
    { auto rr_ = __builtin_amdgcn_permlane32_swap(__float_as_uint(ma_), __float_as_uint(ma_), false, false); ma_ = __builtin_fmaxf(__uint_as_float(rr_[0]), __uint_as_float(rr_[1])); } \
    ma_ = msk_ ? -1e30f : ma_; { const bool keep_ = __all(ma_ - m_reg <= THR_RAW); mnN = keep_ ? m_reg : __builtin_fmaxf(m_reg, ma_); } alN = __builtin_amdgcn_exp2f((m_reg - mnN) * CS); m_reg = mnN; \
    { const float ce_ = msk_ ? 0.f : CS * 8388608.0f, mc_ = msk_ ? -1e30f : (126.955f - mnN * CS) * 8388608.0f; c2_ = (f32x2){ce_, ce_}; m2_ = (f32x2){mc_, mc_}; } \
    _Pragma("unroll") for (int r_ = 0; r_ < 16; r_ += 2) { FM2(N0, r_); FM2(N1, r_); } \
    _Pragma("unroll") for (int r_ = 0; r_ < 16; ++r_) EX2(N0[r_]); _Pragma("unroll") for (int r_ = 0; r_ < 8; ++r_) EX2(N1[r_]); } while (0)
#define QK_ONLY(N0, N1, Kb) do { const char* kb_ = (Kb); const v8i k0_ = LD8(kb_), k1_ = LD8(kb_ + 32 * KPITCH); N0 = MFQK(k0_); N1 = MFQK(k1_); } while (0)
#define FINISH_ONLY(O0, O1, alO) do { f32x2 s2_; _Pragma("unroll") for (int r_ = 8; r_ < 16; ++r_) EX2(O1[r_]); s2_ = (f32x2){O0[0], O0[1]}; \
    _Pragma("unroll") for (int r_ = 2; r_ < 16; r_ += 2) s2_ += (f32x2){O0[r_], O0[r_ + 1]}; _Pragma("unroll") for (int r_ = 0; r_ < 16; r_ += 2) s2_ += (f32x2){O1[r_], O1[r_ + 1]}; \
    { float ps_ = s2_.x + s2_.y; auto rr_ = __builtin_amdgcn_permlane32_swap(__float_as_uint(ps_), __float_as_uint(ps_), false, false); ps_ = __uint_as_float(rr_[0]) + __uint_as_float(rr_[1]); l_reg = l_reg * (alO) + ps_; } \
    _Pragma("unroll") for (int w_ = 0; w_ < 4; ++w_) { p8[w_] = pk4_fp8(O0[4 * w_] * SP, O0[4 * w_ + 1] * SP, O0[4 * w_ + 2] * SP, O0[4 * w_ + 3] * SP); p8[4 + w_] = pk4_fp8(O1[4 * w_] * SP, O1[4 * w_ + 1] * SP, O1[4 * w_ + 2] * SP, O1[4 * w_ + 3] * SP); } } while (0)
#define PV_ONLY(Vb) do { const char* vb_ = (Vb); const v8i v0_ = LD8(vb_), v1_ = LD8(vb_ + 32 * VPITCH), v2_ = LD8(vb_ + 64 * VPITCH), v3_ = LD8(vb_ + 96 * VPITCH); SBAR(); MFPV(0, v0_); MFPV(1, v1_); MFPV(2, v2_); MFPV(3, v3_); SBAR(); } while (0)
  f32x16 pA0 = {}, pA1 = {}, pB0 = {}, pB1 = {}; float mnA = 0.f, mnB = 0.f, alA = 1.f, alB = 1.f; v8i p8 = {};
  constexpr int SE = 0, SO = SDEPTH - 1;
  const bool lag = LAG && wid >= 4;
  SLOAD(SE, 0); asm volatile("s_waitcnt vmcnt(0)" ::: "memory"); SWRITE(0, SE); __syncthreads();
  if (active) { QK_ONLY(pA0, pA1, Kr); SOFT_FIRST(pA0, pA1, mnA, alA, 0); }
  SLOAD(SO, 1); if constexpr (SDEPTH == 2) { if (2 < NT) SLOAD(SE, 2); }
  SWAIT(); SWRITE(1, SO); __syncthreads();
#define KB(t) (Kr + ((t) & 3) * SHM_BUF)
#define VB(t) (Vr + ((t) & 3) * SHM_BUF)
  for (int j = 1; j + 1 < NT; j += 2) {
    if (active) PHASE_A(pB0, pB1, pA0, pA1, alA, KB(j));
    SLOAD(SO, j + SDEPTH); SBAR();
    if (lag) { SWAIT(); SWRITE((j + 1) & 3, SE); __syncthreads(); }
    if (active) { PHASE_B(pB0, pB1, mnB, alB, VB(j - 1), j); RESC(alB); }
    if (!lag) { SWAIT(); SWRITE((j + 1) & 3, SE); __syncthreads(); }
    if (active) PHASE_A(pA0, pA1, pB0, pB1, alB, KB(j + 1));
    if (SDEPTH == 1 || j + 3 < NT) SLOAD(SE, j + 1 + SDEPTH); SBAR();
    if (lag) { SWAIT(); SWRITE((j + 2) & 3, SO); __syncthreads(); }
    if (active) { PHASE_B(pA0, pA1, mnA, alA, VB(j), j + 1); RESC(alA); }
    if (!lag) { SWAIT(); SWRITE((j + 2) & 3, SO); __syncthreads(); }
  }
  if (active) {
    PHASE_A(pB0, pB1, pA0, pA1, alA, KB(NT - 1)); PHASE_B(pB0, pB1, mnB, alB, VB(NT - 2), NT - 1);
    RESC(alB);
    FINISH_ONLY(pB0, pB1, alB); SBAR();
    PV_ONLY(VB(NT - 1)); SBAR(); ONOPS(); SBAR(); }
  __syncthreads();
#undef KB
#undef VB
#undef PHASE_A
#undef PHASE_B
#undef SOFT_FIRST
#undef QK_ONLY
#undef FINISH_ONLY
#undef PV_ONLY
#undef LD8
#undef MFQK
#undef MFPV
#undef EX2
#undef MX3
#undef FM2
  float rli[16];
  if (active) {
    if (hi == 0) li_l[r32] = l_reg; asm volatile("s_waitcnt lgkmcnt(0)" ::: "memory");
#pragma unroll
    for (int r = 0; r < 16; ++r) rli[r] = __builtin_amdgcn_rcpf(li_l[crow(r, hi)]) * (1.0f / (SP * SV));
    if (c == 1) { float* x = (float*)(lds + OFF_XCH) + rb * 4096 + lane;
#pragma unroll
      for (int d0 = 0; d0 < 4; ++d0)
#pragma unroll
        for (int r = 0; r < 16; ++r) x[(d0 * 16 + r) * 64] = o[d0][r] * rli[r]; }
  }
  __syncthreads();
  if (active && c == 0) {
    const float* x = (const float*)(lds + OFF_XCH) + rb * 4096 + lane; float ss[16];
#pragma unroll
    for (int r = 0; r < 16; ++r) ss[r] = 0.f;
#pragma unroll
    for (int d0 = 0; d0 < 4; ++d0)
#pragma unroll
      for (int r = 0; r < 16; ++r) { const float v = o[d0][r] * rli[r] - lam * x[(d0 * 16 + r) * 64]; o[d0][r] = v; ss[r] += v * v; }
#pragma unroll
    for (int r = 0; r < 16; ++r) {
#pragma unroll
      for (int s = 1; s < 32; s <<= 1) ss[r] += __shfl_xor(ss[r], s);
      ss[r] = (1.0f - LAM_INIT) / sqrtf(ss[r] * (1.0f / VD) + RMS_EPS); }
    float gl[4];
#pragma unroll
    for (int d0 = 0; d0 < 4; ++d0) gl[d0] = gsub[d0 * 32 + r32];
#pragma unroll
    for (int r = 0; r < 16; ++r) { unsigned char* orow = Ow + (long)crow(r, hi) * DM + r32;
#pragma unroll
      for (int d0 = 0; d0 < 4; ++d0) { const float v = fminf(fmaxf(o[d0][r] * ss[r] * gl[d0] * epi::MIX_SCALE, -448.f), 448.f); orow[d0 * 32] = (unsigned char)(__builtin_amdgcn_cvt_pk_fp8_f32(v, v, 0, false) & 0xff); } }
  }
  __syncthreads();
#undef SLOAD
#undef SWRITE
#undef SWAIT
#undef RESC
#undef CV8
#undef ONOPS
}
#undef SBAR
}

constexpr int TI_IN = (DM / 64) * (INW / 32), TI_GLU = (1024 / 64) * (2048 / 32), TI_OUT = (DM / 64) * (DM / 32), TI_FF1 = (DM / 64) * (DFF / 32), TI_FF2 = (DFF / 64) * (DM / 32);
constexpr int TI_ALL = TI_IN + TI_GLU + TI_OUT + TI_FF1 + TI_FF2;

__device__ __forceinline__ void xcd_skew(unsigned ticks) {
    if (ticks == 0u) return;
    const unsigned long long t0 = __builtin_amdgcn_s_memrealtime(); const unsigned long long w = (unsigned long long)(xb_xcc_id() & 7u) * ticks;
    while (__builtin_amdgcn_s_memrealtime() - t0 < w) __builtin_amdgcn_s_sleep(8);
}
#ifndef SKEW_IN
#define SKEW_IN 0
#endif
#ifndef SKEW_FF1
#define SKEW_FF1 0
#endif
#ifndef SKEW_FF2
#define SKEW_FF2 0
#endif
#ifndef SKEW_OUT
#define SKEW_OUT 0
#endif
template <class T> __device__ __forceinline__ T* launder_s(T* p) { asm volatile("" : "+s"(p)); return p; }
#define PHASE_LOCALS() int tid = threadIdx.x; asm volatile("" : "+v"(tid)); const int lane = tid & 63, wave = __builtin_amdgcn_readfirstlane(tid >> 6), gw = vcu * NWAVES + wave, NGW = G * NWAVES; \
    KA ka = (KA)__builtin_amdgcn_kernarg_segment_ptr(); asm volatile("" : "+s"(ka)); unsigned char* ws = ka->ws; float* out = ka->out; (void)ka; (void)lane; (void)gw; (void)NGW; (void)ws; (void)out
__global__ void __launch_bounds__(NWAVES * 64, 2) hymba_fwd(Args args) {
    extern __shared__ __attribute__((aligned(16))) unsigned char lds[];
    LAS unsigned char* L = (LAS unsigned char*)lds;
    const int G = gridDim.x, bx = blockIdx.x, vcu = (G % 8 == 0) ? (bx % 8) * (G / 8) + bx / 8 : bx;
    for (int u = threadIdx.x; u < (LDS_BYTES - LDSCTL_OFF) / 4; u += NWAVES * 64) ((LAS unsigned*)(L + LDSCTL_OFF))[u] = 0u;
    __syncthreads();
    XcdBarrier bar = xcd_barrier_post((unsigned*)(((KA)__builtin_amdgcn_kernarg_segment_ptr())->ws + WS_CTL) + CW_BAR, (volatile LAS unsigned*)(L + MISC_OFF) + 8);
#define GRID_BAR() xcd_barrier(bar)
#ifndef ATT_SPOS
#define ATT_SPOS(pu) ((pu) % 9)
#endif
#ifdef NO_SPLIT_TAIL
#define SLAB_ARG nullptr
#define TAIL_ORDER pg8::StaticOrder
#define TAIL_INIT(S, nt) S.init(M, DM, G, bx)
#else
#define SLAB_ARG (const float*)(ws + WS_SLAB)
#define TAIL_ORDER epi::SplitTailOrder
#define TAIL_INIT(S, nt) S.init(DM, G, bx, nt)
#endif
#ifndef PHM
#define PHM 0xFFFF
#endif
#ifndef REP_PHASE
#define REP_PHASE -1
#endif
#define PH(k) for (int rep_ = 0; rep_ < ((k) == REP_PHASE ? 2 : 1); ++rep_) if constexpr (((PHM) >> (k)) & 1)
    PH(0) { PHASE_LOCALS();
        float* MOD = (float*)(ws + WS_MOD);
        for (int job = bx; job < 256; job += G) {
            if (job < 192) skinny36_item<0>(ka, job, L, tid, wave, lane, nullptr, MOD);
            else s5_gen_group(ka, job - 192, L, tid, (bf16*)(ws + WS_BTM), (bf16*)(ws + WS_BTE), (float*)(ws + WS_A16));
        }
        __syncthreads();
        LAS float* scr = (LAS float*)(L + wave * 16384);
        for (int it = gw; it < TI_ALL; it += NGW) {
            int r = it;
            if (r < TI_IN) { const int kb = r / (INW / 32), nb = r % (INW / 32); p0_transpose_item(ka->in[I_WIN], DM, INW, (bf16*)(ws + WS_WIN), nb * 32, scr, kb * 64, nb * 32, lane); continue; } r -= TI_IN;
            if (r < TI_GLU) { const int kb = r / 64, nb = r % 64, n0 = nb * 32; const int wrow0 = n0 < 1024 ? (n0 >> 7) * 256 + (n0 & 127) : ((n0 - 1024) >> 7) * 256 + 128 + (n0 & 127);
                p0_transpose_item8(ka->in[I_WGLU], 1024, 2048, ws + WS_WGLU, wrow0, scr, kb * 64, n0, lane, epi::WGLU_SCALE); continue; } r -= TI_GLU;
            if (r < TI_OUT) { const int kb = r / (DM / 32), nb = r % (DM / 32); p0_transpose_item8(ka->in[I_WOUT], DM, DM, ws + WS_WOUT, nb * 32, scr, kb * 64, nb * 32, lane, epi::WOUT_SCALE); continue; } r -= TI_OUT;
            if (r < TI_FF1) { const int kb = r / (DFF / 32), nb = r % (DFF / 32); p0_transpose_item(ka->in[I_WFF1], DM, DFF, (bf16*)(ws + WS_WFF1), nb * 32, scr, kb * 64, nb * 32, lane); continue; } r -= TI_FF1;
            { const int kb = r / (DM / 32), nb = r % (DM / 32); p0_transpose_item8(ka->in[I_WFF2], DFF, DM, ws + WS_WFF2, nb * 32, scr, kb * 64, nb * 32, lane, epi::W2_SCALE); }
        }
        float* ROPE = (float*)(ws + WS_ROPE);
        for (int e = bx * 512 + tid; e < SEQ * 8; e += G * 512) {
            const int pos = e >> 3, i = e & 7;
            const float inv = (float)d_exp(-(double)i * 0.125 * 13.122363377404328);
            const float ang = (float)pos * inv; double sn, cs; d_sincos((double)ang, sn, cs);
            ROPE[pos * 16 + i] = (float)cs; ROPE[pos * 16 + 8 + i] = (float)sn;
        }
    }
    GRID_BAR();
    PH(1) { PHASE_LOCALS(); norm_mod_pass<0>(ka, (const float*)(ws + WS_MOD), out + O_Y, nullptr, (bf16*)(ws + WS_H), gw, NGW, lane);
        for (int r = gw; r < 64; r += NGW) { bf16* dst = (bf16*)(ws + WS_SHB) + (size_t)r * DM; const float* src = (const float*)(ws + WS_MOD) + (size_t)(r < NMOD ? r : 0) * MODW + 3 * DM;
            for (int c0 = lane; c0 < DM; c0 += 64) dst[c0] = r < NMOD ? (bf16)f2bf(src[c0]) : (bf16)0; } }
    GRID_BAR();
    PH(2) { PHASE_LOCALS();
        pg8::Gemm g{(bf16*)(ws + WS_H), (bf16*)(ws + WS_WIN), DM, DM, DM}; pg8::StaticOrder S; S.init(M, INW, G, bx);
        epi::EpiInProj E{ws + WS_Q, ws + WS_K, ws + WS_V, (bf16*)(ws + WS_UR), out, (const float*)(ws + WS_ROPE)};
        xcd_skew(SKEW_IN);
        pg8::gemm_phase<epi::EpiInProj, pg8::StaticOrder, true, true>(L, g, S, E);
    }
    GRID_BAR();
    PH(3) { PHASE_LOCALS();
        pg8::Gemm g{(bf16*)(ws + WS_UR), (bf16*)(ws + WS_BTE), S5K, 256, 256}; epi::S5Order S{G, bx};
        epi::EpiS5E E{(float*)(ws + WS_E)};
        pg8::gemm_phase<epi::EpiS5E, epi::S5Order, true, true>(L, g, S, E);
    }
    GRID_BAR();
    PH(4) { PHASE_LOCALS(); carry_scan(ka, (const float*)(ws + WS_E), (bf16*)(ws + WS_UR), (const float*)(ws + WS_A16), out, L, vcu, G, wave, lane);
        __syncthreads();
        for (int job = bx; job < DFF / 32; job += G) c2_mfma_item(job, (const bf16*)(ws + WS_SHB), (const bf16*)(ws + WS_WFF1), (float*)(ws + WS_C2), L, wave, lane);
    }
    GRID_BAR();
    PH(5) { PHASE_LOCALS();
        pg8::Gemm g{(bf16*)(ws + WS_UR), (bf16*)(ws + WS_BTM), S5K, S5K, S5K}; epi::S5Order S{G, bx};
        epi::EpiS5Main E{ws + WS_Z};
        pg8::gemm_phase<epi::EpiS5Main, epi::S5Order, true, true>(L, g, S, E);
    }
    PH(6) { PHASE_LOCALS();
        const unsigned char *Q8 = ws + WS_Q, *K8 = ws + WS_K, *VT8 = ws + WS_V; unsigned char* MIX = ws + WS_MIX;
        float lam;
        { const float a1 = wave_sum(ka->in[I_LQ1][lane] * ka->in[I_LK1][lane]), a2 = wave_sum(ka->in[I_LQ2][lane] * ka->in[I_LK2][lane]); lam = __expf(a1) - __expf(a2) + LAM_INIT; }
        const float* gsub = ka->in[I_GSUB];
        for (int pu = vcu; pu < NBP * NH * 8; pu += G) {
            const int bh = pu >> 3, s = pu & 7, b = bh >> 3, h = bh & 7; const int spos = ATT_SPOS(pu);
            int i = 0;
            for (int slot = 0; slot < 9; ++slot) {
                if (slot == spos) {
                    const int bs = pu >> 3, hs = pu & 7; const bool active = wave < 4; const int c = (wave >> 1) & 1, rb = wave & 1;
                    const size_t qrow = (size_t)MP + bs * DSEQ + rb * 32;
                    att::attn_unit<false, 1, false>(Q8 + qrow * AW + hs * 128 + c * 64,
                                             ka->in[I_CK] + (size_t)bs * PAST * AW + hs * 128, ka->in[I_CV] + (size_t)bs * PAST * AW + hs * 128,
                                             out + O_KS + (size_t)bs * DSEQ * AW + hs * 128, out + O_VS + (size_t)bs * DSEQ * AW + hs * 128,
                                             PAST / 64, PAST / 64 + 2, active, c, rb, PAST / 64 + 1, lam, gsub, MIX + qrow * DM + hs * 128, (char*)lds);
                } else {
                    const int c = wave >> 2, rb = wave & 3;
                    const int qb2 = (i >> 1) * 16 + ((i & 1) ? 15 - s : s); ++i;
                    const size_t qrow = (size_t)b * SEQ + qb2 * 128 + rb * 32;
                    const unsigned char* Kh = K8 + (size_t)b * SEQ * AW + h * 128; const unsigned char* Vh = VT8 + (size_t)bh * (SEQ / 64) * 8192;
                    att::attn_unit<true, 2, true>(Q8 + qrow * AW + h * 128 + c * 64, Kh, Vh, Kh, Vh, 2 * qb2 + 2, 2 * qb2 + 2, true, c, rb, 2 * qb2 + (rb >> 1) + 1, lam, gsub, MIX + qrow * DM + h * 128, (char*)lds);
                }
            }
        }
    }
    GRID_BAR();
    PH(7) { PHASE_LOCALS();
        pg8::Gemm g{(bf16*)(ws + WS_Z), (bf16*)(ws + WS_WGLU), 1024, 1024, 1024}; pg8::StaticOrder S; S.init(M, 2048, G, bx);
        epi::EpiGlu E{ws + WS_MIX, ka->in[I_BGLU]};
        pg8::gemm_phase<epi::EpiGlu, pg8::StaticOrder, true, true, true>(L, g, S, E);
    }
    GRID_BAR();
    PH(8) { PHASE_LOCALS();
        pg8::Gemm g{(bf16*)(ws + WS_MIX), (bf16*)(ws + WS_WOUT), DM, DM, DM}; pg8::StaticOrder S; S.init(M, DM, G, bx);
        epi::EpiOut E{ka->in[I_XP], ka->in[I_XS], (bf16*)(ws + WS_H), (float*)(ws + WS_STAT), (const float*)(ws + WS_MOD), ka->in[I_GFFN]};
        xcd_skew(SKEW_OUT);
        pg8::gemm_phase<epi::EpiOut, pg8::StaticOrder, true, true, true>(L, g, S, E);
    }
    GRID_BAR();
    PH(10) { PHASE_LOCALS();
        pg8::Gemm g{(bf16*)(ws + WS_H), (bf16*)(ws + WS_WFF1), DM, DM, DM}; pg8::StaticOrder S; S.init(M, DFF, G, bx);
        epi::EpiFF1 E{ws + WS_HID, (const float*)(ws + WS_STAT), (const float*)(ws + WS_C2)};
        xcd_skew(SKEW_FF1);
        pg8::gemm_phase<epi::EpiFF1, pg8::StaticOrder, true, true>(L, g, S, E);
    }
    GRID_BAR();
    PH(11) { PHASE_LOCALS();
        pg8::Gemm g{(bf16*)(ws + WS_HID), (bf16*)(ws + WS_WFF2), DFF, DFF, DFF}; TAIL_ORDER S; TAIL_INIT(S, DFF / 128);
        epi::EpiFF2 E{(bf16*)(ws + WS_X2), (const float*)(ws + WS_MOD), (float*)(ws + WS_SLAB), (const bf16*)(ws + WS_H), ka->in[I_GFFN]};
        xcd_skew(SKEW_FF2);
        pg8::gemm_phase<epi::EpiFF2, TAIL_ORDER, true, true, true>(L, g, S, E);
    }
    GRID_BAR();
    PH(12) { PHASE_LOCALS(); final_norm_pass(ka, out + O_Y, (const bf16*)(ws + WS_X2), SLAB_ARG, gw, NGW, lane); }
#undef GRID_BAR
}

extern "C" void kernel_launch(void* const* d_in, const int* in_sizes, int n_in, void* d_out, int out_size, void* d_ws, size_t ws_size, hipStream_t stream) {
    static int grid = 0;
    if (grid == 0) {
        if (n_in != N_IN || (size_t)out_size != O_END || ws_size < WS_END) { fprintf(stderr, "kernel_launch: shape mismatch: n_in %d out %d ws %zu (need %d, %zu, >= %zu); nothing launched\n", n_in, out_size, ws_size, (int)N_IN, (size_t)O_END, (size_t)WS_END); grid = -1; return; }
        int dev = 0, cus = 0, per_cu = 0;
        if (hipGetDevice(&dev) != hipSuccess || hipDeviceGetAttribute(&cus, hipDeviceAttributeMultiprocessorCount, dev) != hipSuccess) { fprintf(stderr, "kernel_launch: device query failed\n"); grid = -1; return; }
        if (hipFuncSetAttribute((const void*)hymba_fwd, hipFuncAttributeMaxDynamicSharedMemorySize, LDS_BYTES) != hipSuccess) { fprintf(stderr, "kernel_launch: hipFuncSetAttribute failed\n"); grid = -1; return; }
        if (hipOccupancyMaxActiveBlocksPerMultiprocessor(&per_cu, (const void*)hymba_fwd, NWAVES * 64, LDS_BYTES) != hipSuccess || per_cu < 1) { fprintf(stderr, "kernel_launch: occupancy query reports %d workgroups per CU\n", per_cu); }
        (void)hipGetLastError();
        grid = cus;
    }
    if (grid < 0) return;
    if (hipMemsetAsync((char*)d_ws + WS_CTL, 0, CTL_ZERO_BYTES, stream) != hipSuccess) { fprintf(stderr, "kernel_launch: memset failed\n"); return; }
    Args a{};
    for (int i = 0; i < N_IN; ++i) a.in[i] = (const float*)d_in[i];
    a.out = (float*)d_out; a.ws = (unsigned char*)d_ws;
    hipLaunchKernelGGL(hymba_fwd, dim3(grid), dim3(NWAVES * 64), LDS_BYTES, stream, a);
    const hipError_t le = hipPeekAtLastError();
    if (le != hipSuccess) fprintf(stderr, "kernel_launch: launch failed: %s\n", hipGetErrorName(le));
}
```

```cpp
#include <hip/hip_runtime.h>
#include <cstdio>
#include <cstdint>
#include <type_traits>
namespace pg8 {
#define PG8_LAS __attribute__((address_space(3)))
typedef unsigned short bf16_t;
typedef short bf16x8 __attribute__((ext_vector_type(8)));
typedef float f32x4 __attribute__((ext_vector_type(4)));
typedef unsigned u32x4 __attribute__((ext_vector_type(4)));
constexpr int BM = 256, BK = 64, HALF = 128, HTB = HALF * BK * 2  , STAGE_BYTES = 8 * HTB, NXCD = 8, WGM = 8;

__host__ __device__ __forceinline__ int lds_byte(int r, int c) { const int st = (r >> 4) * 2 + (c >> 5), rr = r & 15, cc = c & 31, ob = rr * 64 + cc * 2; return st * 1024 + (ob ^ (((ob >> 9) & 1) << 5)); }
__host__ __device__ __forceinline__ void stage_rc(int b, int& R, int& C) { const int st = b / 1024, sb = b % 1024, swz = sb ^ (((sb >> 9) & 1) << 5); R = (st >> 1) * 16 + swz / 64; C = (st & 1) * 32 + (swz % 64) / 2; }
__host__ __device__ __forceinline__ int perm32(int rho) { const int n = rho >> 4, i = rho & 15; return 8 * (i >> 2) + 4 * n + (i & 3); }

struct Unit { int pm, pn, k0, nk; };
struct Gemm { const bf16_t* A; const bf16_t* Bt; int lda, ldb, K; };

struct StaticOrder {
    int nM, nN, nwg, G, c;
    __host__ __device__ void init(int M, int N, int G_, int c_) { nM = M / BM; nN = N / BM; nwg = nM * nN; G = G_; c = c_; }
    __host__ __device__ bool next(int i, Unit& u) const {
        const long L = (long)i * G + c; if (L >= nwg) return false;
        int wgid = (int)L; { const int q = nwg / NXCD, r = nwg % NXCD, xcd = wgid % NXCD, off = wgid / NXCD; wgid = (xcd < r ? xcd * (q + 1) : r * (q + 1) + (xcd - r) * q) + off; }
        const int nig = WGM * nN, gid = wgid / nig, fm = gid * WGM, gsz = (nM - fm) < WGM ? (nM - fm) : WGM;
        u.pm = fm + ((wgid % nig) % gsz); u.pn = (wgid % nig) / gsz; u.k0 = 0; u.nk = 0; return true;
    }
    __device__ __forceinline__ void a_ready(const Unit&) const {}
    __device__ __forceinline__ void done(const Unit&) const {}
};

__device__ __forceinline__ unsigned cvt_pk_bf16(float lo, float hi) { unsigned r; asm volatile("v_cvt_pk_bf16_f32 %0, %1, %2" : "=v"(r) : "v"(lo), "v"(hi)); return r; }
template <class Epi, class Sched, bool ALIGN_EPI = false, bool SP2 = false, bool F8 = false>
__device__ __forceinline__ void gemm_phase(PG8_LAS unsigned char* lds, const Gemm g, const Sched& S, const Epi& E) {
    int tid = threadIdx.x; asm volatile("" : "+v"(tid));
    const int wid = __builtin_amdgcn_readfirstlane(tid >> 6), lane = tid & 63, wr = wid >> 2, wc = wid & 3, fr = lane & 15, fq = lane >> 4;
    constexpr int ESZ = F8 ? 1 : 2;
    const int ntfull = g.K * ESZ / 128;
    unsigned voffA[2], voffB[2];
#pragma unroll
    for (int i = 0; i < 2; ++i) { int R, C; stage_rc(tid * 16 + i * 8192, R, C); const int Rb = Epi::PERM ? ((R & ~31) + perm32(R & 31)) : R;
        voffA[i] = (unsigned)(R * g.lda * ESZ + C * 2); voffB[i] = (unsigned)(Rb * g.ldb * ESZ + C * 2); }
    const size_t kstep = (size_t)(BK * 2);
    const size_t hstepA = (size_t)HALF * g.lda * ESZ, hstepB = (size_t)HALF * g.ldb * ESZ;
    const size_t tstepA = 2 * hstepA, tstepB = 2 * hstepB;
    const unsigned ldsw = (unsigned)wid * 1024u;
    const int aoff = lds_byte(wr * 64 + fr, fq * 8), boff = lds_byte(wc * 32 + fr, fq * 8);
#define PG8_SA(b, h) (((b) * 2 + (h)) * HTB)
#define PG8_SB(b, h) ((4 + (b) * 2 + (h)) * HTB)
#define PG8_STAGE(bufoff, gbase, voff) do { _Pragma("unroll") for (int _i = 0; _i < 2; ++_i) \
        __builtin_amdgcn_global_load_lds((const unsigned*)((const char*)(gbase) + (voff)[_i]), (PG8_LAS unsigned*)(lds + (bufoff) + ldsw + _i * 8192), 16, 0, 0); } while (0)
#define PG8_LDA(dst, b, h) do { _Pragma("unroll") for (int m = 0; m < 4; ++m) _Pragma("unroll") for (int k = 0; k < 2; ++k) dst[m][k] = *(const PG8_LAS bf16x8*)(lds + PG8_SA(b, h) + aoff + m * 2048 + k * 1024); } while (0)
#define PG8_LDB(dst, b, h) do { _Pragma("unroll") for (int n = 0; n < 2; ++n) _Pragma("unroll") for (int k = 0; k < 2; ++k) dst[n][k] = *(const PG8_LAS bf16x8*)(lds + PG8_SB(b, h) + boff + n * 2048 + k * 1024); } while (0)
#define PG8_MMA(ai, bj, At, Bt) do { __builtin_amdgcn_s_setprio(1); _Pragma("unroll") for (int m = 0; m < 4; ++m) _Pragma("unroll") for (int n = 0; n < 2; ++n) { \
        if constexpr (F8) { typedef int v4i_ __attribute__((ext_vector_type(4))); typedef int v8i_ __attribute__((ext_vector_type(8))); \
            const v8i_ bq_ = __builtin_shufflevector(__builtin_bit_cast(v4i_, Bt[n][0]), __builtin_bit_cast(v4i_, Bt[n][1]), 0, 1, 2, 3, 4, 5, 6, 7); \
            const v8i_ aq_ = __builtin_shufflevector(__builtin_bit_cast(v4i_, At[m][0]), __builtin_bit_cast(v4i_, At[m][1]), 0, 1, 2, 3, 4, 5, 6, 7); \
            asm volatile("v_mfma_f32_16x16x128_f8f6f4 %0, %1, %2, %0" : "+v"(acc[ai][bj][m][n]) : "v"(bq_), "v"(aq_)); } \
        else { _Pragma("unroll") for (int k = 0; k < 2; ++k) acc[ai][bj][m][n] = __builtin_amdgcn_mfma_f32_16x16x32_bf16(Bt[n][k], At[m][k], acc[ai][bj][m][n], 0, 0, 0); } } \
        __builtin_amdgcn_s_setprio(0); } while (0)
#define PG8_WAIT_V(n) asm volatile("s_waitcnt vmcnt(" #n ")" ::: "memory")
#define PG8_WAIT_L(n) asm volatile("s_waitcnt lgkmcnt(" #n ")" ::: "memory")
#define PG8_BAR __builtin_amdgcn_s_barrier()
#define PG8_SCHED __builtin_amdgcn_sched_barrier(0)
    Unit cur, nxt; int ui = 0;
    if (!S.next(0, cur)) return;
    f32x4 acc[2][2][4][2];
#pragma unroll
    for (int a = 0; a < 2; ++a)
#pragma unroll
        for (int b = 0; b < 2; ++b)
#pragma unroll
            for (int m = 0; m < 4; ++m)
#pragma unroll
                for (int n = 0; n < 2; ++n) acc[a][b][m][n] = (f32x4){0.f, 0.f, 0.f, 0.f};
    bf16x8 At[4][2], B0[2][2], B1[2][2];
    const char* cA = (const char*)g.A + (size_t)cur.pm * tstepA + (size_t)cur.k0 * kstep; const char* cB = (const char*)g.Bt + (size_t)cur.pn * tstepB + (size_t)cur.k0 * kstep;
    int nt = cur.nk ? cur.nk : ntfull;
    S.a_ready(cur);
    if constexpr (SP2) {
        PG8_STAGE(PG8_SB(0, 0), cB, voffB); PG8_STAGE(PG8_SB(0, 1), cB + hstepB, voffB); PG8_STAGE(PG8_SA(0, 0), cA, voffA); PG8_STAGE(PG8_SA(0, 1), cA + hstepA, voffA);
        if (wr == 1) PG8_BAR;
        PG8_WAIT_V(2); PG8_BAR;
        PG8_STAGE(PG8_SB(1, 0), cB + kstep, voffB); PG8_STAGE(PG8_SA(1, 0), cA + kstep, voffA); PG8_STAGE(PG8_SB(1, 1), cB + hstepB + kstep, voffB);
        PG8_WAIT_V(6); PG8_BAR;
    } else {
        PG8_STAGE(PG8_SB(0, 0), cB, voffB); PG8_STAGE(PG8_SA(0, 0), cA, voffA); PG8_STAGE(PG8_SB(0, 1), cB + hstepB, voffB); PG8_STAGE(PG8_SA(0, 1), cA + hstepA, voffA);
        if (wr == 1) PG8_BAR;
        PG8_WAIT_V(4); PG8_BAR;
        PG8_STAGE(PG8_SB(1, 0), cB + kstep, voffB); PG8_STAGE(PG8_SA(1, 0), cA + kstep, voffA); PG8_STAGE(PG8_SB(1, 1), cB + hstepB + kstep, voffB);
        PG8_WAIT_V(6); PG8_BAR;
    }
    for (;;) {
        const bool has_next = S.next(ui + 1, nxt);
        const char* nA = has_next ? (const char*)g.A + (size_t)nxt.pm * tstepA + (size_t)nxt.k0 * kstep : cA; const char* nB = has_next ? (const char*)g.Bt + (size_t)nxt.pn * tstepB + (size_t)nxt.k0 * kstep : cB;
#pragma unroll 1
        for (int t = 0; t < nt; t += 2) {
            const bool last = (t == nt - 2);
            const char* a1 = cA + (size_t)(t + 1) * kstep;
            const char* a2 = last ? nA : cA + (size_t)(t + 2) * kstep; const char* b2 = last ? nB : cB + (size_t)(t + 2) * kstep;
            const char* a3 = a2 + kstep; const char* b3 = b2 + kstep;
            if (last && has_next) S.a_ready(nxt);
            if constexpr (SP2) {
            PG8_LDB(B0, 0, 0); PG8_LDB(B1, 0, 1); PG8_SCHED; PG8_LDA(At, 0, 0); PG8_STAGE(PG8_SA(1, 1), a1 + hstepA, voffA);
            PG8_WAIT_V(8); PG8_WAIT_L(0); PG8_BAR; PG8_MMA(0, 0, At, B0); PG8_MMA(0, 1, At, B1); PG8_BAR; PG8_SCHED;
            PG8_LDA(At, 0, 1); PG8_STAGE(PG8_SB(0, 0), b2, voffB); PG8_STAGE(PG8_SB(0, 1), b2 + hstepB, voffB); PG8_STAGE(PG8_SA(0, 0), a2, voffA);
            PG8_WAIT_V(8); PG8_WAIT_L(0); PG8_BAR; PG8_MMA(1, 0, At, B0); PG8_MMA(1, 1, At, B1); PG8_BAR; PG8_SCHED;
            PG8_LDB(B0, 1, 0); PG8_LDB(B1, 1, 1); PG8_SCHED; PG8_LDA(At, 1, 0); PG8_STAGE(PG8_SA(0, 1), a2 + hstepA, voffA);
            PG8_WAIT_V(8); PG8_WAIT_L(0); PG8_BAR; PG8_MMA(0, 0, At, B0); PG8_MMA(0, 1, At, B1); PG8_BAR; PG8_SCHED;
            PG8_LDA(At, 1, 1); PG8_STAGE(PG8_SB(1, 0), b3, voffB); PG8_STAGE(PG8_SB(1, 1), b3 + hstepB, voffB); PG8_STAGE(PG8_SA(1, 0), a3, voffA);
            PG8_WAIT_V(8); PG8_WAIT_L(0); PG8_BAR; PG8_MMA(1, 0, At, B0); PG8_MMA(1, 1, At, B1); PG8_BAR; PG8_SCHED;
            } else {
            PG8_LDB(B0, 0, 0); PG8_SCHED; PG8_LDA(At, 0, 0); PG8_STAGE(PG8_SA(1, 1), a1 + hstepA, voffA);
            PG8_WAIT_L(8); PG8_BAR; PG8_WAIT_L(0); PG8_MMA(0, 0, At, B0); PG8_BAR; PG8_SCHED;
            PG8_LDB(B1, 0, 1); PG8_STAGE(PG8_SB(0, 0), b2, voffB);
            PG8_BAR; PG8_WAIT_L(0); PG8_MMA(0, 1, At, B1); PG8_BAR;
            PG8_LDA(At, 0, 1); PG8_STAGE(PG8_SA(0, 0), a2, voffA);
            PG8_BAR; PG8_WAIT_L(0); PG8_MMA(1, 0, At, B0); PG8_BAR; PG8_SCHED;
            PG8_STAGE(PG8_SB(0, 1), b2 + hstepB, voffB);
            PG8_WAIT_V(6); PG8_BAR; PG8_MMA(1, 1, At, B1); PG8_BAR;
            PG8_LDB(B0, 1, 0); PG8_SCHED; PG8_LDA(At, 1, 0); PG8_STAGE(PG8_SA(0, 1), a2 + hstepA, voffA);
            PG8_WAIT_L(8); PG8_BAR; PG8_WAIT_L(0); PG8_MMA(0, 0, At, B0); PG8_BAR; PG8_SCHED;
            PG8_LDB(B1, 1, 1); PG8_STAGE(PG8_SB(1, 0), b3, voffB);
            PG8_BAR; PG8_WAIT_L(0); PG8_MMA(0, 1, At, B1); PG8_BAR;
            PG8_LDA(At, 1, 1); PG8_STAGE(PG8_SA(1, 0), a3, voffA);
            PG8_BAR; PG8_WAIT_L(0); PG8_MMA(1, 0, At, B0); PG8_BAR; PG8_SCHED;
            PG8_STAGE(PG8_SB(1, 1), b3 + hstepB, voffB);
            PG8_WAIT_V(6); PG8_BAR; PG8_MMA(1, 1, At, B1); PG8_BAR;
            }
        }
        if constexpr (ALIGN_EPI) { if (wr == 0) PG8_BAR; }
        if constexpr (F8) { PG8_SCHED; asm volatile("s_nop 15\n\ts_nop 15" ::: "memory"); PG8_SCHED; }
        if constexpr (!Epi::AFTER_DRAIN) { E(acc, cur, wr, wc, fr, fq); S.done(cur); }
        if (!has_next) break;
#pragma unroll
        for (int a = 0; a < 2; ++a)
#pragma unroll
            for (int b = 0; b < 2; ++b)
#pragma unroll
                for (int m = 0; m < 4; ++m)
#pragma unroll
                    for (int n = 0; n < 2; ++n) acc[a][b][m][n] = (f32x4){0.f, 0.f, 0.f, 0.f};
        cur = nxt; cA = nA; cB = nB; ++ui; nt = cur.nk ? cur.nk : ntfull;
        if constexpr (ALIGN_EPI) { if (wr == 1) PG8_BAR; }
    }
    PG8_WAIT_V(0);
    if constexpr (!ALIGN_EPI) { if (wr == 0) PG8_BAR; }
    PG8_BAR;
    if constexpr (Epi::AFTER_DRAIN) { E.fused(acc, cur, wr, wc, fr, fq, lds, wid, lane); S.done(cur); }
#undef PG8_SA
#undef PG8_SB
#undef PG8_STAGE
#undef PG8_LDA
#undef PG8_LDB
#undef PG8_MMA
#undef PG8_WAIT_V
#undef PG8_WAIT_L
#undef PG8_BAR
#undef PG8_SCHED
}
}
#define GAS __attribute__((address_space(1)))
#define LAS __attribute__((address_space(3)))
typedef unsigned short bf16;
typedef unsigned v4u __attribute__((ext_vector_type(4)));
typedef float f32x4 __attribute__((ext_vector_type(4)));
typedef short bf16x8 __attribute__((ext_vector_type(8)));
typedef GAS unsigned gu32;
typedef GAS unsigned long long gu64;
#define RLX_AGENT __ATOMIC_RELAXED, __HIP_MEMORY_SCOPE_AGENT
#define LDS_WAIT() asm volatile("s_waitcnt lgkmcnt(0)" ::: "memory")
#define VM_WAIT() asm volatile("s_waitcnt vmcnt(0)" ::: "memory")
__device__ __forceinline__ unsigned long long rt() { return __builtin_amdgcn_s_memrealtime(); }
__device__ __forceinline__ unsigned f2bf(float f) { unsigned u = __builtin_bit_cast(unsigned, f); return (u + 0x7fffu + ((u >> 16) & 1u)) >> 16; }
__device__ __forceinline__ unsigned pk2(float lo, float hi) { return f2bf(lo) | (f2bf(hi) << 16); }
#define XB_TMO      128
#define XB_XCNT(j)  (256  + 64 * (j))
#define XB_XSUB(j)  (1280 + 64 * (j))
#define XB_XGEN(j)  (2304 + 64 * (j))
#define XB_TOP      3328
#define XB_TOPGEN   3392
#define XCD_BAR_WORDS 3456
#define XB_SPIN_CAP (1u << 18)

__device__ __forceinline__ unsigned xb_ld(unsigned* p)              { return __hip_atomic_load(p, __ATOMIC_RELAXED, __HIP_MEMORY_SCOPE_AGENT); }
__device__ __forceinline__ unsigned xb_add(unsigned* p, unsigned v) { return __hip_atomic_fetch_add(p, v, __ATOMIC_RELAXED, __HIP_MEMORY_SCOPE_AGENT); }
__device__ __forceinline__ unsigned xb_xcc_id() { return (unsigned)__builtin_amdgcn_s_getreg((3 << 11) | 20) & 0xFu; }
#define XB_SPIN(cond, bar) do { unsigned _sp = 0; while (cond) { __builtin_amdgcn_s_sleep(1); \
    if ((++_sp & 255u) == 0u) { if (xb_ld(&(bar)[XB_TMO])) break; if (_sp > XB_SPIN_CAP) { atomicAdd(&(bar)[XB_TMO], 1u); break; } } } } while (0)

struct XcdBarrier {
    unsigned* bar; unsigned x;
    volatile LAS unsigned* st;
};

__device__ __forceinline__ XcdBarrier xcd_barrier_post(unsigned* bar, volatile LAS unsigned* st) {
    XcdBarrier b; b.bar = bar; b.x = xb_xcc_id(); b.st = st;
    if (threadIdx.x == 0) (void)xb_add(&bar[XB_XCNT(b.x)], 1u);
    return b;
}
__device__ __forceinline__ void xcd_barrier_complete(unsigned* bar, unsigned x, unsigned& nloc, unsigned& nx) {
    const unsigned G = gridDim.x * gridDim.y * gridDim.z;
    unsigned sum, cnt, mine, sp = 0u;
    for (;;) {
        sum = 0u; cnt = 0u; mine = 0u;
#pragma unroll
        for (unsigned j = 0; j < 16; ++j) { const unsigned c = xb_ld(&bar[XB_XCNT(j)]); sum += c; cnt += (c > 0u) ? 1u : 0u; mine = (j == x) ? c : mine; }
        if (sum == G) break;
        __builtin_amdgcn_s_sleep(1);
        if ((++sp & 255u) == 0u) { if (xb_ld(&bar[XB_TMO])) break; if (sp > XB_SPIN_CAP) { atomicAdd(&bar[XB_TMO], 1u); break; } }
    }
    nloc = mine > 0u ? mine : 1u; nx = cnt > 0u ? cnt : 1u;
}

__device__ __forceinline__ void xcd_barrier(const XcdBarrier& b) {
    asm volatile("s_waitcnt vmcnt(0)" ::: "memory");
    __syncthreads();
    if (threadIdx.x == 0) {
        unsigned* bar = b.bar;
        __builtin_amdgcn_s_waitcnt(0);
        unsigned nloc = b.st[0], nx = b.st[1];
        if (nloc == 0u) { xcd_barrier_complete(bar, b.x, nloc, nx); b.st[0] = nloc; b.st[1] = nx; }
        const unsigned old = xb_add(&bar[XB_XSUB(b.x)], 1u);
        const unsigned gen = old / nloc;
        if (old + 1u == (gen + 1u) * nloc) {
            __builtin_amdgcn_fence(__ATOMIC_RELEASE, "agent");
            asm volatile("s_waitcnt vmcnt(0)" ::: "memory");
            const unsigned og = xb_add(&bar[XB_TOP], 1u);
            const unsigned tg = og / nx;
            if (og + 1u == (tg + 1u) * nx) xb_add(&bar[XB_TOPGEN], 1u);
            else XB_SPIN(xb_ld(&bar[XB_TOPGEN]) == tg, bar);
            __builtin_amdgcn_fence(__ATOMIC_ACQUIRE, "agent");
            xb_add(&bar[XB_XGEN(b.x)], 1u);
            asm volatile("s_waitcnt vmcnt(0)" ::: "memory");
        } else {
            XB_SPIN(xb_ld(&bar[XB_XGEN(b.x)]) == gen, bar);
            __builtin_amdgcn_fence(__ATOMIC_ACQUIRE, "agent");
            asm volatile("s_waitcnt vmcnt(0)" ::: "memory");
        }
    }
    __syncthreads();
}

constexpr int DM = 2048, NBP = 4, SEQ = 8192, NBS = 32, DSEQ = 64, PAST = 2048;
constexpr int MP = NBP * SEQ, MS = NBS * DSEQ, M = MP + MS;
constexpr int AW = 1024, NH = 8, HD = 64, VD = 128, INW = 4096, DFF = 8192;
constexpr int SG = 64, SP = 64, SH = 16;
constexpr int TS = 16;
constexpr int NROW = M / TS, S5NT = 9, NROWP = S5NT * 256, S5K = 384;
constexpr int NMOD = 36, MODW = 6 * DM;
constexpr float RMS_EPS = 1e-6f;
constexpr float LAM_INIT = 0.2f;
constexpr size_t O_Y = 0, O_KP = (size_t)M * DM, O_VP = O_KP + (size_t)MP * AW, O_SRP = O_VP + (size_t)MP * AW, O_SIP = O_SRP + (size_t)NBP * SG * SP,
                 O_KS = O_SIP + (size_t)NBP * SG * SP, O_VS = O_KS + (size_t)MS * AW, O_SRS = O_VS + (size_t)MS * AW, O_SIS = O_SRS + (size_t)NBS * SG * SP, O_END = O_SIS + (size_t)NBS * SG * SP;
static_assert(O_END == 142901248, "output size");
enum { I_XP = 0, I_XS, I_CP, I_CS, I_CK, I_CV, I_SRE, I_SIM, I_WADA, I_BADA, I_GMIX, I_WIN, I_LQ1, I_LK1, I_LQ2, I_LK2, I_GSUB, I_LRE, I_LIM, I_LDT, I_BRE, I_BIM, I_CRE, I_CIM, I_SD, I_WGLU, I_BGLU, I_WOUT, I_GFFN, I_WFF1, I_WFF2, I_GFIN, N_IN };
static_assert(N_IN == 32, "inputs");

constexpr size_t MiB = 1u << 20;
constexpr size_t WS_CTL = 0, CTL_ZERO_BYTES = 1 * MiB;
constexpr size_t WS_A16 = 1 * MiB;
constexpr size_t WS_ROPE = 2 * MiB;
constexpr size_t WS_MOD = 3 * MiB;
constexpr size_t WS_WIN = 8 * MiB, WS_WGLU = 24 * MiB, WS_WOUT = 28 * MiB, WS_WFF1 = 36 * MiB, WS_WFF2 = 68 * MiB;
constexpr size_t WS_BTM = 100 * MiB;
constexpr size_t WS_BTE = 112 * MiB;
constexpr size_t WS_H = 120 * MiB;
constexpr size_t WS_E = WS_H, WS_Z = WS_H + 68 * MiB;
constexpr size_t WS_Q = 256 * MiB, WS_K = 324 * MiB, WS_V = 388 * MiB, WS_UR = 452 * MiB, WS_MIX = 560 * MiB;
constexpr size_t WS_C2 = 5 * MiB, WS_SHB = 7 * MiB;
constexpr size_t WS_X2 = 560 * MiB;
constexpr size_t WS_HID = 256 * MiB, WS_SLAB = 800 * MiB, WS_STAT = 864 * MiB, WS_END = 872 * MiB;
static_assert(WS_WIN + (size_t)INW * DM * 2 <= WS_WGLU && WS_WGLU + (size_t)2048 * 1024 * 2 <= WS_WOUT && WS_WOUT + (size_t)DM * DM * 2 <= WS_WFF1 && WS_WFF1 + (size_t)DFF * DM * 2 <= WS_WFF2 && WS_WFF2 + (size_t)DM * DFF * 2 <= WS_BTM, "ws map 1");
static_assert(WS_BTM + (size_t)SG * 256 * S5K * 2 <= WS_BTE && WS_BTE + (size_t)SG * 256 * 256 * 2 <= WS_H && WS_H + (size_t)M * DM * 2 <= WS_Q, "ws map 2");
static_assert((size_t)SG * NROW * 128 * 4 <= 68 * MiB && (size_t)M * AW * 2 <= 68 * MiB, "E|Z");
static_assert(WS_Q + (size_t)M * AW * 2 <= WS_K && WS_K + (size_t)MP * AW * 2 <= WS_V && WS_V + (size_t)MP * AW * 2 <= WS_UR && WS_UR + (size_t)SG * NROWP * S5K * 2 <= WS_MIX && WS_MIX + (size_t)M * DM * 2 <= WS_SLAB, "ws map 3");
static_assert(WS_HID + (size_t)M * DFF * 2 <= WS_SLAB && WS_SLAB + (size_t)4 * MS * DM * 4 <= WS_STAT && WS_STAT + (size_t)M * 32 * 4 <= WS_END && WS_C2 + (size_t)NMOD * DFF * 4 <= WS_SHB && WS_SHB + 64 * DM * 2 <= WS_WIN && WS_MOD + (size_t)NMOD * MODW * 4 <= WS_WIN, "ws map 4");
constexpr int CW_BAR = 4096;

constexpr int RING_BYTES = 135168;
constexpr int LDSCTL_OFF = RING_BYTES, MISC_OFF = LDSCTL_OFF + 320;
constexpr int LDS_BYTES = 147456;
static_assert(MISC_OFF + 128 <= LDS_BYTES, "LDS map");
constexpr int NWAVES = 8;

namespace epi {
constexpr float HID_SCALE = 8.0f, W2_SCALE = 64.0f;
constexpr float Z_SCALE = 16.0f, WGLU_SCALE = 32.0f;
constexpr float MIX_SCALE = 16.0f, WOUT_SCALE = 32.0f;
constexpr float ATT_SQ = 16.0f, ATT_SK = 16.0f, ATT_SV = 16.0f, ATT_SP = 16.0f;
__device__ __forceinline__ int vpos(int key) { return ((key >> 2) & 1) * 32 + (key >> 5) * 16 + ((key >> 3) & 3) * 4 + (key & 3); }
using pg8::f32x4; using pg8::u32x4; using pg8::Unit; using pg8::cvt_pk_bf16; using pg8::bf16_t;
typedef float (accT)[4];
__device__ __forceinline__ u32x4 pack8(const f32x4& a, const f32x4& b) { u32x4 w; w.x = cvt_pk_bf16(a[0], a[1]); w.y = cvt_pk_bf16(a[2], a[3]); w.z = cvt_pk_bf16(b[0], b[1]); w.w = cvt_pk_bf16(b[2], b[3]); return w; }
typedef unsigned u32x2 __attribute__((ext_vector_type(2)));
__device__ __forceinline__ u32x2 pack8_fp8(f32x4 a, f32x4 b, float s) {
#pragma unroll
    for (int j = 0; j < 4; ++j) { a[j] = fminf(fmaxf(a[j] * s, -448.f), 448.f); b[j] = fminf(fmaxf(b[j] * s, -448.f), 448.f); }
    int w0 = __builtin_amdgcn_cvt_pk_fp8_f32(a[0], a[1], 0, false); w0 = __builtin_amdgcn_cvt_pk_fp8_f32(a[2], a[3], w0, true);
    int w1 = __builtin_amdgcn_cvt_pk_fp8_f32(b[0], b[1], 0, false); w1 = __builtin_amdgcn_cvt_pk_fp8_f32(b[2], b[3], w1, true);
    return (u32x2){(unsigned)w0, (unsigned)w1}; }
__device__ __forceinline__ void atom_add4(float* p, const f32x4& v) {
#pragma unroll
    for (int j = 0; j < 4; ++j) __builtin_amdgcn_global_atomic_fadd_f32((__attribute__((address_space(1))) float*)(p + j), v[j]); }
__device__ __forceinline__ int batch_of_tile(int pm, int ai, int wr) { return pm < 128 ? (pm >> 5) : 4 + (pm - 128) * 4 + 2 * ai + wr; }

struct EpiInProj {
    static constexpr bool PERM = true, AFTER_DRAIN = false;
    unsigned char* Q8; unsigned char* K8; unsigned char* VT8; bf16_t* Ur; float* out; const float* rope;
    __device__ __forceinline__ void operator()(const f32x4 (&acc)[2][2][4][2], const Unit& u, int wr, int wc, int fr, int fq) const {
        const int sect = u.pn >> 2, colt = (u.pn & 3) * 256 + wc * 32 + 8 * fq;
        const bool smp = u.pm >= 128;
        const int row0 = u.pm * 256 + wr * 64 + fr;
        if (sect <= 1) {
            const bool rot_wave = (wc & 1) == 0;
            float* okv = out + (smp ? O_KS : O_KP);
#pragma unroll
            for (int ai = 0; ai < 2; ++ai)
#pragma unroll
                for (int m = 0; m < 4; ++m) {
                    const int row = row0 + ai * 128 + m * 16;
                    const int pos = smp ? PAST + ((row - MP) & 63) : (row & (SEQ - 1));
                    f32x4 c0 = {1.f, 1.f, 1.f, 1.f}, c1 = c0, s0 = {0.f, 0.f, 0.f, 0.f}, s1 = s0;
                    if (rot_wave && fq < 2) { const f32x4* rp = (const f32x4*)(rope + (size_t)pos * 16); c0 = rp[0]; c1 = rp[1]; s0 = rp[2]; s1 = rp[3]; if (fq == 0) { s0 = -s0; s1 = -s1; } }
#pragma unroll
                    for (int bj = 0; bj < 2; ++bj) {
                        f32x4 v0 = acc[ai][bj][m][0], v1 = acc[ai][bj][m][1];
                        if (rot_wave) {
                            f32x4 p0, p1;
#pragma unroll
                            for (int j = 0; j < 4; ++j) { p0[j] = __shfl_xor(v0[j], 16); p1[j] = __shfl_xor(v1[j], 16); }
                            if (fq < 2) { v0 = v0 * c0 + p0 * s0; v1 = v1 * c1 + p1 * s1; }
                        }
                        const int col = colt + bj * 128;
                        if (sect == 0) { *(u32x2*)(Q8 + (size_t)row * AW + col) = pack8_fp8(v0, v1, ATT_SQ); }
                        else {
                            float* o = okv + (size_t)(smp ? row - MP : row) * AW + col; *(f32x4*)o = v0; *(f32x4*)(o + 4) = v1;
                            if (!smp) *(u32x2*)(K8 + (size_t)row * AW + col) = pack8_fp8(v0, v1, ATT_SK);
                        }
                    }
                }
        } else if (sect == 2) {
            float* okv = out + (smp ? O_VS : O_VP);
#pragma unroll
            for (int ai = 0; ai < 2; ++ai)
#pragma unroll
                for (int m = 0; m < 4; ++m) {
                    const int row = row0 + ai * 128 + m * 16;
#pragma unroll
                    for (int bj = 0; bj < 2; ++bj) {
                        const f32x4 v0 = acc[ai][bj][m][0], v1 = acc[ai][bj][m][1]; const int col = colt + bj * 128;
                        float* o = okv + (size_t)(smp ? row - MP : row) * AW + col; *(f32x4*)o = v0; *(f32x4*)(o + 4) = v1;
                        if (!smp) { const u32x2 w = pack8_fp8(v0, v1, ATT_SV); const int bb = row >> 13, t = row & (SEQ - 1), hh = col >> 7, dd = col & 127;
                            unsigned char* vp = VT8 + ((size_t)((bb * NH + hh) * (SEQ / 64) + (t >> 6)) * 128 + dd) * 64 + vpos(t & 63);
#pragma unroll
                            for (int x = 0; x < 8; ++x) vp[x * 64] = (unsigned char)(w[x >> 2] >> (8 * (x & 3))); }
                    }
                }
        } else {
#pragma unroll
            for (int ai = 0; ai < 2; ++ai)
#pragma unroll
                for (int m = 0; m < 4; ++m) {
                    const int row = row0 + ai * 128 + m * 16;
#pragma unroll
                    for (int bj = 0; bj < 2; ++bj) {
                        const int col = colt + bj * 128, g = col >> 4, h0 = col & 15;
                        *(u32x4*)(Ur + ((size_t)g * NROWP + (row >> 4)) * S5K + (row & 15) * 16 + h0) = pack8(acc[ai][bj][m][0], acc[ai][bj][m][1]);
                    }
                }
        }
    }
};

struct EpiS5E {
    static constexpr bool PERM = true, AFTER_DRAIN = false;
    float* E;
    __device__ __forceinline__ void operator()(const f32x4 (&acc)[2][2][4][2], const Unit& u, int wr, int wc, int fr, int fq) const {
        const int g = u.pn, rt = u.pm - S5NT * g, row0 = rt * 256 + wr * 64 + fr, col = wc * 32 + 8 * fq;
#pragma unroll
        for (int ai = 0; ai < 2; ++ai)
#pragma unroll
            for (int m = 0; m < 4; ++m) { const int row = row0 + ai * 128 + m * 16;
                if (row < NROW) { float* o = E + ((size_t)g * NROW + row) * 128 + col; *(f32x4*)o = acc[ai][0][m][0]; *(f32x4*)(o + 4) = acc[ai][0][m][1]; } }
    }
};

__device__ __forceinline__ float gelu_tanh(float x) {
    const float y = x * (0.7978845608028654f + 0.035677408136300125f * x * x);
    const float e = __builtin_amdgcn_exp2f(y * 2.8853900817779268f);
    return x - x * __builtin_amdgcn_rcpf(e + 1.0f);
}
struct EpiS5Main {
    static constexpr bool PERM = true, AFTER_DRAIN = false;
    unsigned char* Z;
    __device__ __forceinline__ void operator()(const f32x4 (&acc)[2][2][4][2], const Unit& u, int wr, int wc, int fr, int fq) const {
        const int g = u.pn, rt = u.pm - S5NT * g, row0 = rt * 256 + wr * 64 + fr;
#pragma unroll
        for (int ai = 0; ai < 2; ++ai)
#pragma unroll
            for (int m = 0; m < 4; ++m) { const int row = row0 + ai * 128 + m * 16;
                if (row < NROW) {
#pragma unroll
                    for (int bj = 0; bj < 2; ++bj) { const int n0 = bj * 128 + wc * 32 + 8 * fq, t = n0 >> 4, h0 = n0 & 15;
                        f32x4 v0 = acc[ai][bj][m][0], v1 = acc[ai][bj][m][1];
#pragma unroll
                        for (int j = 0; j < 4; ++j) { v0[j] = gelu_tanh(v0[j]); v1[j] = gelu_tanh(v1[j]); }
                        *(u32x2*)(Z + (size_t)(row * TS + t) * AW + g * 16 + h0) = pack8_fp8(v0, v1, Z_SCALE); __builtin_amdgcn_sched_barrier(0); } } }
    }
};

struct EpiGlu {
    static constexpr bool PERM = true, AFTER_DRAIN = false;
    unsigned char* MIX; const float* bglu;
    __device__ __forceinline__ void operator()(const f32x4 (&acc)[2][2][4][2], const Unit& u, int wr, int wc, int fr, int fq) const {
        const int row0 = u.pm * 256 + wr * 64 + fr, col = u.pn * 128 + wc * 32 + 8 * fq;
        const f32x4 bv0 = *(const f32x4*)(bglu + col), bv1 = *(const f32x4*)(bglu + col + 4), bg0 = *(const f32x4*)(bglu + 1024 + col), bg1 = *(const f32x4*)(bglu + 1024 + col + 4);
#pragma unroll
        for (int ai = 0; ai < 2; ++ai)
#pragma unroll
            for (int m = 0; m < 4; ++m) { const int row = row0 + ai * 128 + m * 16;
                constexpr float RS = 1.0f / (Z_SCALE * WGLU_SCALE);
                f32x4 v0 = acc[ai][0][m][0] * RS + bv0, v1 = acc[ai][0][m][1] * RS + bv1; const f32x4 g0 = acc[ai][1][m][0] * RS + bg0, g1 = acc[ai][1][m][1] * RS + bg1;
#pragma unroll
                for (int j = 0; j < 4; ++j) { v0[j] = v0[j] * __builtin_amdgcn_rcpf(1.0f + __builtin_amdgcn_exp2f(-1.4426950408889634f * g0[j])); v1[j] = v1[j] * __builtin_amdgcn_rcpf(1.0f + __builtin_amdgcn_exp2f(-1.4426950408889634f * g1[j])); }
                *(u32x2*)(MIX + (size_t)row * DM + 1024 + col) = pack8_fp8(v0, v1, MIX_SCALE); __builtin_amdgcn_sched_barrier(0); }
    }
};

struct EpiOut {
    static constexpr bool PERM = true, AFTER_DRAIN = false;
    const float* xp; const float* xs; bf16_t* H2; float* stat; const float* mod; const float* gffn;
    __device__ __forceinline__ void operator()(const f32x4 (&acc)[2][2][4][2], const Unit& u, int wr, int wc, int fr, int fq) const {
        const int row0 = u.pm * 256 + wr * 64 + fr, col0 = u.pn * 256 + wc * 32 + 8 * fq;
        const float* xb = u.pm < 128 ? xp : xs - (size_t)MP * DM;
#pragma unroll
        for (int ai = 0; ai < 2; ++ai) {
            const float* mp = mod + (size_t)batch_of_tile(u.pm, ai, wr) * MODW + col0;
            f32x4 gt[2][2], gs[2][2];
#pragma unroll
            for (int bj = 0; bj < 2; ++bj)
#pragma unroll
                for (int n = 0; n < 2; ++n) { gt[bj][n] = *(const f32x4*)(mp + 2 * DM + bj * 128 + 4 * n) * (1.0f / (MIX_SCALE * WOUT_SCALE));
                    gs[bj][n] = *(const f32x4*)(gffn + col0 + bj * 128 + 4 * n) * (*(const f32x4*)(mp + 4 * DM + bj * 128 + 4 * n) + 1.0f); }
#pragma unroll
            for (int m = 0; m < 4; ++m) { const int row = row0 + ai * 128 + m * 16; const size_t off = (size_t)row * DM + col0; float ss = 0.f;
#pragma unroll
                for (int bj = 0; bj < 2; ++bj) { const f32x4 a0 = *(const f32x4*)(xb + off + bj * 128) + gt[bj][0] * acc[ai][bj][m][0], a1 = *(const f32x4*)(xb + off + bj * 128 + 4) + gt[bj][1] * acc[ai][bj][m][1];
                    ss += (a0[0] * a0[0] + a0[1] * a0[1]) + (a0[2] * a0[2] + a0[3] * a0[3]) + (a1[0] * a1[0] + a1[1] * a1[1]) + (a1[2] * a1[2] + a1[3] * a1[3]);
                    *(u32x4*)(H2 + off + bj * 128) = pack8(a0 * gs[bj][0], a1 * gs[bj][1]); }
                ss += __shfl_xor(ss, 16); ss += __shfl_xor(ss, 32);
                if (fq == 0) stat[(size_t)row * 32 + u.pn * 4 + wc] = ss;
                asm volatile("" ::: "memory"); }
        }
    }
};

struct EpiFF1 {
    static constexpr bool PERM = true, AFTER_DRAIN = false;
    unsigned char* HID; const float* stat; const float* c2;
    __device__ __forceinline__ void operator()(const f32x4 (&acc)[2][2][4][2], const Unit& u, int wr, int wc, int fr, int fq) const {
        const int row0 = u.pm * 256 + wr * 64 + fr, col0 = u.pn * 256 + wc * 32 + 8 * fq;
#pragma unroll
        for (int ai = 0; ai < 2; ++ai) {
            const float* cp = c2 + (size_t)batch_of_tile(u.pm, ai, wr) * DFF + col0;
            f32x4 cv[2][2];
#pragma unroll
            for (int bj = 0; bj < 2; ++bj)
#pragma unroll
                for (int n = 0; n < 2; ++n) cv[bj][n] = *(const f32x4*)(cp + bj * 128 + 4 * n);
#pragma unroll
            for (int m = 0; m < 4; ++m) { const int row = row0 + ai * 128 + m * 16; unsigned char* rowp = HID + (size_t)row * DFF + col0;
                const f32x4 s0 = *(const f32x4*)(stat + (size_t)row * 32 + 8 * fq), s1 = *(const f32x4*)(stat + (size_t)row * 32 + 8 * fq + 4);
                float ss = ((s0[0] + s0[1]) + (s0[2] + s0[3])) + ((s1[0] + s1[1]) + (s1[2] + s1[3]));
                ss += __shfl_xor(ss, 16); ss += __shfl_xor(ss, 32);
                const float rs = (1.0f / sqrtf(ss * (1.0f / DM) + RMS_EPS)) * 2.8284271247461903f  ;
#pragma unroll
                for (int bj = 0; bj < 2; ++bj) { constexpr float CL = 21.166010488516726f  ;
                    f32x4 v0 = acc[ai][bj][m][0] * rs + cv[bj][0] * 2.8284271247461903f, v1 = acc[ai][bj][m][1] * rs + cv[bj][1] * 2.8284271247461903f;
#pragma unroll
                    for (int j = 0; j < 4; ++j) { v0[j] = __builtin_amdgcn_fmed3f(v0[j], 0.f, CL); v1[j] = __builtin_amdgcn_fmed3f(v1[j], 0.f, CL); }
                    v0 = v0 * v0; v1 = v1 * v1;
                    int w0 = __builtin_amdgcn_cvt_pk_fp8_f32(v0[0], v0[1], 0, false); w0 = __builtin_amdgcn_cvt_pk_fp8_f32(v0[2], v0[3], w0, true);
                    int w1 = __builtin_amdgcn_cvt_pk_fp8_f32(v1[0], v1[1], 0, false); w1 = __builtin_amdgcn_cvt_pk_fp8_f32(v1[2], v1[3], w1, true);
                    *(u32x2*)(rowp + bj * 128) = (u32x2){(unsigned)w0, (unsigned)w1}; } }
        }
    }
};

struct EpiFF2 {
    static constexpr bool PERM = true, AFTER_DRAIN = false;
    bf16_t* X2; const float* mod; float* slab; const bf16_t* H2; const float* gffn;
    __device__ __forceinline__ void operator()(const f32x4 (&acc)[2][2][4][2], const Unit& u, int wr, int wc, int fr, int fq) const {
        const int row0 = u.pm * 256 + wr * 64 + fr, col0 = u.pn * 256 + wc * 32 + 8 * fq;
        const int q = u.nk ? u.k0 / u.nk : 0;
#pragma unroll
        for (int ai = 0; ai < 2; ++ai) {
            const float* mp = mod + (size_t)batch_of_tile(u.pm, ai, wr) * MODW + col0;
            f32x4 gt[2][2], rg[2][2];
#pragma unroll
            for (int bj = 0; bj < 2; ++bj)
#pragma unroll
                for (int n = 0; n < 2; ++n) { gt[bj][n] = *(const f32x4*)(mp + 5 * DM + bj * 128 + 4 * n) * (1.0f / (HID_SCALE * W2_SCALE));
                    const f32x4 g = *(const f32x4*)(gffn + col0 + bj * 128 + 4 * n) * (*(const f32x4*)(mp + 4 * DM + bj * 128 + 4 * n) + 1.0f);
#pragma unroll
                    for (int j = 0; j < 4; ++j) rg[bj][n][j] = fabsf(g[j]) > 1e-20f ? 1.0f / g[j] : 0.f; }
#pragma unroll
            for (int m = 0; m < 4; ++m) { const size_t off = (size_t)(row0 + ai * 128 + m * 16) * DM + col0;
#pragma unroll
                for (int bj = 0; bj < 2; ++bj) {
                    const f32x4 p0 = gt[bj][0] * acc[ai][bj][m][0], p1 = gt[bj][1] * acc[ai][bj][m][1];
                    if (q != 0) { float* sp = slab + (size_t)q * ((size_t)MS * DM) + (off - (size_t)MP * DM) + bj * 128; *(f32x4*)sp = p0; *(f32x4*)(sp + 4) = p1; }
                    else { const u32x4 hw = *(const u32x4*)(H2 + off + bj * 128); f32x4 x0, x1;
                        x0[0] = __uint_as_float(hw[0] << 16); x0[1] = __uint_as_float(hw[0] & 0xffff0000u); x0[2] = __uint_as_float(hw[1] << 16); x0[3] = __uint_as_float(hw[1] & 0xffff0000u);
                        x1[0] = __uint_as_float(hw[2] << 16); x1[1] = __uint_as_float(hw[2] & 0xffff0000u); x1[2] = __uint_as_float(hw[3] << 16); x1[3] = __uint_as_float(hw[3] & 0xffff0000u);
                        *(u32x4*)(X2 + off + bj * 128) = pack8(x0 * rg[bj][0] + p0, x1 * rg[bj][1] + p1); } }
                asm volatile("" ::: "memory"); }
        }
    }
};

struct S5Order {
    int G, c;
    __device__ __forceinline__ bool next(int i, Unit& u) const { const int L = i * G + c; if (L >= SG * S5NT) return false; const int g = L / S5NT; u.pm = L; u.pn = g; u.k0 = 0; u.nk = 0; return true; }
    __device__ __forceinline__ void a_ready(const Unit&) const {}
    __device__ __forceinline__ void done(const Unit&) const {}
};
struct SplitTailOrder {
    pg8::StaticOrder full; int c, ntile;
    __device__ __forceinline__ void init(int N, int G_, int c_, int ntile_) { full.init(128 * 256, N, G_, c_); c = c_; ntile = ntile_; }
    __device__ __forceinline__ bool next(int i, Unit& u) const {
        if (full.next(i, u)) return true;
        if (i != full.nwg / full.G) return false;
        const int x = c & 7, j = c >> 3; u.pm = 128 + x; u.pn = j >> 2; u.k0 = (j & 3) * (ntile >> 2); u.nk = ntile >> 2; return true;
    }
    __device__ __forceinline__ void a_ready(const Unit&) const {}
    __device__ __forceinline__ void done(const Unit&) const {}
};
}

__device__ __forceinline__ float wave_sum(float v) {
#pragma unroll
    for (int o = 1; o < 64; o <<= 1) v += __shfl_xor(v, o);
    return v;
}
__device__ __forceinline__ double d_exp(double x) {
    const double k = __builtin_rint(x * 1.4426950408889634074);
    double r = __builtin_fma(-k, 6.93147180369123816490e-01, x); r = __builtin_fma(-k, 1.90821492927058770002e-10, r);
    double p = 1.0 / 6227020800.0;
    p = __builtin_fma(p, r, 1.0 / 479001600.0); p = __builtin_fma(p, r, 1.0 / 39916800.0); p = __builtin_fma(p, r, 1.0 / 3628800.0); p = __builtin_fma(p, r, 1.0 / 362880.0);
    p = __builtin_fma(p, r, 1.0 / 40320.0); p = __builtin_fma(p, r, 1.0 / 5040.0); p = __builtin_fma(p, r, 1.0 / 720.0); p = __builtin_fma(p, r, 1.0 / 120.0);
    p = __builtin_fma(p, r, 1.0 / 24.0); p = __builtin_fma(p, r, 1.0 / 6.0); p = __builtin_fma(p, r, 0.5); p = __builtin_fma(p, r, 1.0); p = __builtin_fma(p, r, 1.0);
    return ldexp(p, (int)k);
}
__device__ __forceinline__ void d_sincos(double x, double& s, double& c) {
    const double k = __builtin_rint(x * 0.63661977236758134308);
    double r = __builtin_fma(-k, 1.57079632673412561417e+00, x); r = __builtin_fma(-k, 6.07710050650619224932e-11, r);
    const double r2 = r * r;
    double ps = -1.0 / 1307674368000.0;
    ps = __builtin_fma(ps, r2, 1.0 / 6227020800.0); ps = __builtin_fma(ps, r2, -1.0 / 39916800.0); ps = __builtin_fma(ps, r2, 1.0 / 362880.0); ps = __builtin_fma(ps, r2, -1.0 / 5040.0);
    ps = __builtin_fma(ps, r2, 1.0 / 120.0); ps = __builtin_fma(ps, r2, -1.0 / 6.0); const double S = __builtin_fma(ps * r2, r, r);
    double pc = 1.0 / 20922789888000.0;
    pc = __builtin_fma(pc, r2, -1.0 / 87178291200.0); pc = __builtin_fma(pc, r2, 1.0 / 479001600.0); pc = __builtin_fma(pc, r2, -1.0 / 3628800.0); pc = __builtin_fma(pc, r2, 1.0 / 40320.0);
    pc = __builtin_fma(pc, r2, -1.0 / 720.0); pc = __builtin_fma(pc, r2, 1.0 / 24.0); pc = __builtin_fma(pc, r2, -0.5); const double C = __builtin_fma(pc, r2, 1.0);
    const int q = ((int)k) & 3;
    s = (q == 0) ? S : (q == 1) ? C : (q == 2) ? -S : -C;
    c = (q == 0) ? C : (q == 1) ? -S : (q == 2) ? -C : S;
}

struct Args { const float* in[32]; float* out; unsigned char* ws; };
typedef const __attribute__((address_space(4))) Args* KA;

__device__ __forceinline__ void p0_transpose_item(const float* W, int K, int N, bf16* WT, int wrow0, LAS float* scr, int k0, int n0, int lane) {
    float tv[32];
#pragma unroll
    for (int i = 0; i < 32; ++i) { const int kk = 2 * i + (lane >> 5); tv[i] = W[(size_t)(k0 + kk) * N + n0 + (lane & 31)]; }
#pragma unroll
    for (int i = 0; i < 32; ++i) { const int kk = 2 * i + (lane >> 5); scr[kk * 33 + (lane & 31)] = tv[i]; }
    LDS_WAIT(); asm volatile("" ::: "memory");
    const int c = lane & 7;
#pragma unroll
    for (int j = 0; j < 4; ++j) { const int n = (lane >> 3) + 8 * j; const LAS float* s = scr + (8 * c) * 33 + n;
        v4u o; o.x = pk2(s[0 * 33], s[1 * 33]); o.y = pk2(s[2 * 33], s[3 * 33]); o.z = pk2(s[4 * 33], s[5 * 33]); o.w = pk2(s[6 * 33], s[7 * 33]);
        *(GAS v4u*)(WT + (size_t)(wrow0 + n) * K + k0 + 8 * c) = o; }
    LDS_WAIT(); asm volatile("" ::: "memory");
}

__device__ __forceinline__ void p0_transpose_item8(const float* W, int K, int N, unsigned char* WT, int wrow0, LAS float* scr, int k0, int n0, int lane, float scale) {
    float tv[32];
#pragma unroll
    for (int i = 0; i < 32; ++i) { const int kk = 2 * i + (lane >> 5); tv[i] = W[(size_t)(k0 + kk) * N + n0 + (lane & 31)]; }
#pragma unroll
    for (int i = 0; i < 32; ++i) { const int kk = 2 * i + (lane >> 5); scr[kk * 33 + (lane & 31)] = tv[i]; }
    LDS_WAIT(); asm volatile("" ::: "memory");
    const int c = lane & 3;
#pragma unroll
    for (int j = 0; j < 2; ++j) { const int n = (lane >> 2) + 16 * j; const LAS float* s = scr + (16 * c) * 33 + n; v4u o;
#pragma unroll
        for (int w = 0; w < 4; ++w) { int x = __builtin_amdgcn_cvt_pk_fp8_f32(s[(4 * w + 0) * 33] * scale, s[(4 * w + 1) * 33] * scale, 0, false); x = __builtin_amdgcn_cvt_pk_fp8_f32(s[(4 * w + 2) * 33] * scale, s[(4 * w + 3) * 33] * scale, x, true); o[w] = (unsigned)x; }
        *(GAS v4u*)(WT + (size_t)(wrow0 + n) * K + k0 + 16 * c) = o; }
    LDS_WAIT(); asm volatile("" ::: "memory");
}

template <int MODE> __device__ __forceinline__ void skinny36_item(KA a, int it, LAS unsigned char* lds, int tid, int wave, int lane, const float* MODr, float* outp) {
    LAS float* S = (LAS float*)lds;
    const float* W = a->in[MODE == 0 ? I_WADA : I_WFF1]; const float* cp = a->in[I_CP]; const float* cs = a->in[I_CS];
    constexpr int LDW = MODE == 0 ? MODW : DFF, NPASS = MODE == 0 ? 4 : 2;
    const int n0 = (MODE == 0 ? it : (it >> 1)) * 64, kbase = MODE == 0 ? 0 : (it & 1) * 1024;
    float acc[36];
#pragma unroll
    for (int i = 0; i < 36; ++i) acc[i] = 0.f;
    for (int q = 0; q < NPASS; ++q) {
        __syncthreads();
        unsigned toff = (unsigned)tid * 4u; asm volatile("" : "+v"(toff));
#pragma unroll 4
        for (int bb = 0; bb < 36; ++bb) { float sv;
            if (MODE == 0) { const float* rp = bb < 4 ? cp + bb * DM + q * 512 : cs + (bb - 4) * DM + q * 512; const float c = *(const float*)((const char*)rp + toff); sv = c / (1.0f + __expf(-c)); }
            else { const float* rp = MODr + (size_t)bb * MODW + 3 * DM + kbase + q * 512; sv = *(const float*)((const char*)rp + toff); }
            S[tid * 36 + bb] = sv; }
        __syncthreads();
        const float* wp = W + (size_t)(kbase + q * 512 + wave * 64) * LDW + n0 + lane;
#pragma unroll 1
        for (int kk0 = 0; kk0 < 64; kk0 += 16) {
            float wv[16];
#pragma unroll
            for (int x = 0; x < 16; ++x) wv[x] = wp[(size_t)(kk0 + x) * LDW];
#pragma unroll
            for (int x = 0; x < 16; ++x) { const LAS f32x4* sp = (const LAS f32x4*)(S + (wave * 64 + kk0 + x) * 36);
#pragma unroll
                for (int q4 = 0; q4 < 9; ++q4) { const f32x4 s4 = sp[q4]; acc[4 * q4 + 0] += s4.x * wv[x]; acc[4 * q4 + 1] += s4.y * wv[x]; acc[4 * q4 + 2] += s4.z * wv[x]; acc[4 * q4 + 3] += s4.w * wv[x]; } }
        }
    }
    __syncthreads();
    LAS float* R = (LAS float*)lds;
#pragma unroll
    for (int bb = 0; bb < 36; ++bb) R[(wave * 36 + bb) * 64 + lane] = acc[bb];
    __syncthreads();
    for (int o = tid; o < 36 * 64; o += 512) { const int bb = o >> 6, ln = o & 63; float s = MODE == 0 ? a->in[I_BADA][n0 + ln] : 0.f;
#pragma unroll
        for (int w = 0; w < 8; ++w) s += R[(w * 36 + bb) * 64 + ln];
        if (MODE == 0) outp[(size_t)bb * MODW + n0 + ln] = s; else outp[((size_t)(it & 1) * NMOD + bb) * DFF + n0 + ln] = s; }
    __syncthreads();
}

__device__ __forceinline__ void c2_mfma_item(int blk, const bf16* SHB, const bf16* W1T, float* C2, LAS unsigned char* lds, int wave, int lane) {
    typedef float f32x16_ __attribute__((ext_vector_type(16)));
    const int r32 = lane & 31, hi = lane >> 5, n0 = blk * 32;
    const bf16* ap = SHB + (size_t)r32 * DM + wave * 256 + hi * 8; const bf16* bp = W1T + (size_t)(n0 + r32) * DM + wave * 256 + hi * 8;
    f32x16_ c0 = {}, c1 = {};
#pragma unroll 4
    for (int ks = 0; ks < 16; ++ks) {
        const bf16x8 a0 = *(const bf16x8*)(ap + ks * 16), a1 = *(const bf16x8*)(ap + 32 * DM + ks * 16), b = *(const bf16x8*)(bp + ks * 16);
        c0 = __builtin_amdgcn_mfma_f32_32x32x16_bf16(a0, b, c0, 0, 0, 0); c1 = __builtin_amdgcn_mfma_f32_32x32x16_bf16(a1, b, c1, 0, 0, 0);
    }
    LAS float* R = (LAS float*)lds;
    __syncthreads();
#pragma unroll
    for (int r = 0; r < 16; ++r) { const int row = (r & 3) + 8 * (r >> 2) + 4 * hi; R[(wave * 36 + row) * 32 + r32] = c0[r]; if (row < 4) R[(wave * 36 + 32 + row) * 32 + r32] = c1[r]; }
    __syncthreads();
    for (int o = (int)threadIdx.x; o < 36 * 32; o += 512) { const int row = o >> 5, col = o & 31; float s = 0.f;
#pragma unroll
        for (int w = 0; w < 8; ++w) s += R[(w * 36 + row) * 32 + col];
        C2[(size_t)row * DFF + n0 + col] = s; }
    __syncthreads();
}

__device__ __forceinline__ void s5_gen_group(KA a, int g, LAS unsigned char* lds, int tid, bf16* BTM, bf16* BTE, float* A16) {
    LAS float* APOW = (LAS float*)lds;
    LAS float* BB = APOW + 17 * 64 * 2;
    LAS float* CC = BB + 64 * 16 * 2;
    LAS float* KM = CC + 16 * 64 * 2;
    __syncthreads();
    if (tid < 64) {
        const int p = tid;
        const double dt = d_exp((double)a->in[I_LDT][g]);
        const double lre = (double)a->in[I_LRE][g * SP + p], lim = (double)a->in[I_LIM][g * SP + p];
        double a1r = 1.0, a1i = 0.0;
        for (int m = 0; m <= 16; ++m) {
            const double mag = d_exp(lre * dt * (double)m); double sn, cs; d_sincos(lim * dt * (double)m, sn, cs);
            const double ar = mag * cs, ai = mag * sn;
            APOW[(m * 64 + p) * 2 + 0] = (float)ar; APOW[(m * 64 + p) * 2 + 1] = (float)ai;
            if (m == 1) { a1r = ar; a1i = ai; }
            if (m == 16) { A16[(g * SP + p) * 2 + 0] = (float)ar; A16[(g * SP + p) * 2 + 1] = (float)ai; }
        }
        const double den = lre * lre + lim * lim;
        const double fre = ((a1r - 1.0) * lre + a1i * lim) / den, fim = (a1i * lre - (a1r - 1.0) * lim) / den;
        for (int h = 0; h < SH; ++h) {
            const double br = (double)a->in[I_BRE][(g * SP + p) * SH + h], bi = (double)a->in[I_BIM][(g * SP + p) * SH + h];
            BB[(p * 16 + h) * 2 + 0] = (float)(fre * br - fim * bi); BB[(p * 16 + h) * 2 + 1] = (float)(fre * bi + fim * br);
        }
    }
    for (int e = tid; e < SH * SP; e += 512) { CC[e * 2 + 0] = a->in[I_CRE][g * SH * SP + e]; CC[e * 2 + 1] = a->in[I_CIM][g * SH * SP + e]; }
    __syncthreads();
    for (int e = tid; e < 16 * 16 * 16; e += 512) {
        const int m = e >> 8, h = (e >> 4) & 15, h2 = e & 15; float s = 0.f;
        for (int p = 0; p < SP; ++p) {
            const float cr = CC[(h * 64 + p) * 2], ci = CC[(h * 64 + p) * 2 + 1], ar = APOW[(m * 64 + p) * 2], ai = APOW[(m * 64 + p) * 2 + 1];
            const float wr = cr * ar - ci * ai, wi = cr * ai + ci * ar;
            s += wr * BB[(p * 16 + h2) * 2] - wi * BB[(p * 16 + h2) * 2 + 1];
        }
        if (m == 0 && h == h2) s += a->in[I_SD][g * SH + h];
        KM[e] = s;
    }
    __syncthreads();
    for (int q = tid; q < 256 * 48; q += 512) {
        const int n = q / 48, kp = q - n * 48, t = n >> 4, h = n & 15; float v[8];
        if (kp < 32) { const int j = kp >> 1, h0 = (kp & 1) * 8;
#pragma unroll
            for (int x = 0; x < 8; ++x) v[x] = (t >= j) ? KM[((t - j) * 16 + h) * 16 + h0 + x] : 0.f;
        } else { const int kk0 = (kp - 32) * 8, p0 = kk0 & 63, im = kk0 >> 6;
#pragma unroll
            for (int x = 0; x < 8; ++x) { const int p = p0 + x; const float cr = CC[(h * 64 + p) * 2], ci = CC[(h * 64 + p) * 2 + 1], ar = APOW[((t + 1) * 64 + p) * 2], ai = APOW[((t + 1) * 64 + p) * 2 + 1];
                v[x] = im ? (-cr * ai - ci * ar) : (cr * ar - ci * ai); }
        }
        v4u o; o.x = pk2(v[0], v[1]); o.y = pk2(v[2], v[3]); o.z = pk2(v[4], v[5]); o.w = pk2(v[6], v[7]);
        *(GAS v4u*)(BTM + ((size_t)g * 256 + n) * S5K + 8 * kp) = o;
    }
    for (int q = tid; q < 128 * 32; q += 512) {
        const int n = q >> 5, kp = q & 31, j = kp >> 1, h0 = (kp & 1) * 8, p = n & 63, im = n >> 6; float v[8];
        const float ar = APOW[((15 - j) * 64 + p) * 2], ai = APOW[((15 - j) * 64 + p) * 2 + 1];
#pragma unroll
        for (int x = 0; x < 8; ++x) { const float br = BB[(p * 16 + h0 + x) * 2], bi = BB[(p * 16 + h0 + x) * 2 + 1]; v[x] = im ? (ar * bi + ai * br) : (ar * br - ai * bi); }
        v4u o; o.x = pk2(v[0], v[1]); o.y = pk2(v[2], v[3]); o.z = pk2(v[4], v[5]); o.w = pk2(v[6], v[7]);
        *(GAS v4u*)(BTE + ((size_t)g * 256 + n) * 256 + 8 * kp) = o;
    }
    __syncthreads();
}

__device__ __forceinline__ int batch_of_row(int r) { return r < MP ? (r >> 13) : 4 + ((r - MP) >> 6); }
template <int WHICH> __device__ __forceinline__ void norm_mod_pass(KA a, const float* MOD, const float* Y, float* Yw, bf16* H, int gw, int ngw, int lane) {
    const int per = (M + ngw - 1) / ngw, r0 = gw * per, r1 = (r0 + per < M) ? r0 + per : M;
    const float* gvec = a->in[WHICH == 0 ? I_GMIX : I_GFFN]; const float* xp = a->in[I_XP]; const float* xs = a->in[I_XS];
    const int sh_chunk = WHICH == 0 ? 0 : 3, sc_chunk = WHICH == 0 ? 1 : 4;
    int cur_b = -1; f32x4 gs[8], sh[8], v[8], vn[8];
#pragma unroll
    for (int j = 0; j < 8; ++j) { gs[j] = (f32x4){0.f, 0.f, 0.f, 0.f}; sh[j] = gs[j]; vn[j] = gs[j]; }
#define ROWSRC(r) (WHICH == 0 ? ((r) < MP ? xp + (size_t)(r) * DM : xs + (size_t)((r) - MP) * DM) : Y + (size_t)(r) * DM)
    if (r0 < r1) { const float* s0 = ROWSRC(r0);
#pragma unroll
        for (int j = 0; j < 8; ++j) vn[j] = *(const f32x4*)(s0 + 4 * lane + 256 * j); }
    for (int r = r0; r < r1; ++r) {
#pragma unroll
        for (int j = 0; j < 8; ++j) v[j] = vn[j];
        if (r + 1 < r1) { const float* s1 = ROWSRC(r + 1);
#pragma unroll
            for (int j = 0; j < 8; ++j) vn[j] = *(const f32x4*)(s1 + 4 * lane + 256 * j); }
        const int b = batch_of_row(r);
        if (b != cur_b) { cur_b = b; const float* mp = MOD + (size_t)b * MODW;
#pragma unroll
            for (int j = 0; j < 8; ++j) { const int k = 4 * lane + 256 * j; const f32x4 g4 = *(const f32x4*)(gvec + k), s4 = *(const f32x4*)(mp + sc_chunk * DM + k); gs[j] = g4 * (s4 + 1.0f); sh[j] = *(const f32x4*)(mp + sh_chunk * DM + k); } }
        float ss = 0.f;
#pragma unroll
        for (int j = 0; j < 8; ++j) ss += (v[j].x * v[j].x + v[j].y * v[j].y) + (v[j].z * v[j].z + v[j].w * v[j].w);
        const float rstd = 1.0f / sqrtf(wave_sum(ss) * (1.0f / DM) + RMS_EPS);
        bf16* dst = H + (size_t)r * DM + 4 * lane;
#pragma unroll
        for (int j = 0; j < 8; ++j) { const f32x4 h = v[j] * rstd * gs[j] + sh[j];
            *(GAS unsigned long long*)(dst + 256 * j) = (unsigned long long)pk2(h.x, h.y) | ((unsigned long long)pk2(h.z, h.w) << 32); }
    }
#undef ROWSRC
    (void)Yw;
}
__device__ __forceinline__ void final_norm_pass(KA a, float* Y, const bf16* X2, const float* slab, int gw, int ngw, int lane) {
    typedef unsigned u32x2_ __attribute__((ext_vector_type(2)));
    const float* gvec = a->in[I_GFIN]; f32x4 g4[8], v[8]; u32x2_ vn[8];
#pragma unroll
    for (int j = 0; j < 8; ++j) { g4[j] = *(const f32x4*)(gvec + 4 * lane + 256 * j); vn[j] = (u32x2_){0u, 0u}; }
    if (gw < M) { const bf16* s0 = X2 + (size_t)gw * DM + 4 * lane;
#pragma unroll
        for (int j = 0; j < 8; ++j) vn[j] = *(const u32x2_*)(s0 + 256 * j); }
    for (int r = gw; r < M; r += ngw) {
        float* row = Y + (size_t)r * DM + 4 * lane; float ss = 0.f;
#pragma unroll
        for (int j = 0; j < 8; ++j) v[j] = (f32x4){__uint_as_float(vn[j].x << 16), __uint_as_float(vn[j].x & 0xffff0000u), __uint_as_float(vn[j].y << 16), __uint_as_float(vn[j].y & 0xffff0000u)};
        if (r + ngw < M) { const bf16* s1 = X2 + (size_t)(r + ngw) * DM + 4 * lane;
#pragma unroll
            for (int j = 0; j < 8; ++j) vn[j] = *(const u32x2_*)(s1 + 256 * j); }
        if (slab && r >= MP) { const float* sp = slab + (size_t)(r - MP) * DM + 4 * lane;
#pragma unroll
            for (int q = 1; q < 4; ++q)
#pragma unroll
                for (int j = 0; j < 8; ++j) v[j] = v[j] + *(const f32x4*)(sp + (size_t)q * MS * DM + 256 * j); }
#pragma unroll
        for (int j = 0; j < 8; ++j) ss += (v[j].x * v[j].x + v[j].y * v[j].y) + (v[j].z * v[j].z + v[j].w * v[j].w);
        const float rstd = 1.0f / sqrtf(wave_sum(ss) * (1.0f / DM) + RMS_EPS);
#pragma unroll
        for (int j = 0; j < 8; ++j) *(f32x4*)(row + 256 * j) = v[j] * rstd * g4[j];
    }
}

template <int NSTEP, bool STORE> __device__ __forceinline__ void carry_steps(const float* __restrict__ Eg, bf16* __restrict__ Ug, int row0, int p, float a16r, float a16i, float& hr, float& hi) {
    float er[NSTEP], ei[NSTEP];
#pragma unroll
    for (int k = 0; k < NSTEP; ++k) { er[k] = Eg[(size_t)(row0 + k) * 128 + p]; ei[k] = Eg[(size_t)(row0 + k) * 128 + 64 + p]; }
#pragma unroll
    for (int k = 0; k < NSTEP; ++k) {
        if (STORE) { bf16* u = Ug + (size_t)(row0 + k) * S5K + 256 + p; u[0] = (bf16)f2bf(hr); u[64] = (bf16)f2bf(hi); }
        const float nr = a16r * hr - a16i * hi + er[k], ni = a16r * hi + a16i * hr + ei[k]; hr = nr; hi = ni;
    }
}
__device__ __forceinline__ void carry_scan(KA a, const float* E, bf16* Ur, const float* A16, float* out, LAS unsigned char* lds, int vcu, int G, int wave, int lane) {
    const int p = lane;
    for (int s = vcu * NWAVES + wave; s < NBS * SG; s += G * NWAVES) {
        const int bs = s >> 6, g = s & 63; const float a16r = A16[(g * SP + p) * 2], a16i = A16[(g * SP + p) * 2 + 1];
        float hr = a->in[I_SRE][(bs * SG + g) * SP + p], hi = a->in[I_SIM][(bs * SG + g) * SP + p];
        carry_steps<4, true>(E + (size_t)g * NROW * 128, Ur + (size_t)g * NROWP * S5K, MP / TS + bs * 4, p, a16r, a16i, hr, hi);
        out[O_SRS + (bs * SG + g) * SP + p] = hr; out[O_SIS + (bs * SG + g) * SP + p] = hi;
    }
    LAS float* SEGL = (LAS float*)lds;
    for (int l = vcu; l < NBP * SG; l += G) {
        const int b = l >> 6, g = l & 63, seg = wave; const float a16r = A16[(g * SP + p) * 2], a16i = A16[(g * SP + p) * 2 + 1];
        const float* Eg = E + (size_t)g * NROW * 128; bf16* Ug = Ur + (size_t)g * NROWP * S5K; const int row0 = b * (SEQ / TS) + seg * 64;
        float hr = 0.f, hi = 0.f;
#pragma unroll 1
        for (int k0 = 0; k0 < 64; k0 += 16) carry_steps<16, false>(Eg, Ug, row0 + k0, p, a16r, a16i, hr, hi);
        __syncthreads();
        SEGL[(seg * 64 + p) * 2] = hr; SEGL[(seg * 64 + p) * 2 + 1] = hi;
        __syncthreads();
        float pr = a16r, pi = a16i;
#pragma unroll
        for (int q = 0; q < 6; ++q) { const float nr = pr * pr - pi * pi, ni = 2.f * pr * pi; pr = nr; pi = ni; }
        hr = 0.f; hi = 0.f;
        for (int s2 = 0; s2 < seg; ++s2) { const float lr = SEGL[(s2 * 64 + p) * 2], li = SEGL[(s2 * 64 + p) * 2 + 1]; const float nr = pr * hr - pi * hi + lr, ni = pr * hi + pi * hr + li; hr = nr; hi = ni; }
#pragma unroll 1
        for (int k0 = 0; k0 < 64; k0 += 16) carry_steps<16, true>(Eg, Ug, row0 + k0, p, a16r, a16i, hr, hi);
        if (seg == 7) { out[O_SRP + (b * SG + g) * SP + p] = hr; out[O_SIP + (b * SG + g) * SP + p] = hi; }
    }
}

namespace att {
using f32x16 = __attribute__((ext_vector_type(16))) float;
using f32x8  = __attribute__((ext_vector_type(8))) float;
using v4i    = __attribute__((ext_vector_type(4))) int;
using v8i    = __attribute__((ext_vector_type(8))) int;
typedef float f32x2 __attribute__((ext_vector_type(2)));
constexpr int KVBLK = 64;
constexpr float SCALE = 0.125f;
constexpr float SQ = epi::ATT_SQ, SK = epi::ATT_SK, SP = epi::ATT_SP, SV = epi::ATT_SV;
constexpr float CS = SCALE * 1.4426950408889634f / (SQ * SK);
constexpr float THR_RAW = 4.0f / CS;
constexpr int KPITCH = 144, VPITCH = 80;
constexpr int SHM_K = KVBLK * KPITCH, SHM_V = 128 * VPITCH, SHM_BUF = SHM_K + SHM_V;
constexpr int NBUF = 3;
constexpr int OFF_BUF = 0, OFF_WS = NBUF * SHM_BUF, OFF_XCH = OFF_WS + NWAVES * 64 * 4, ATT_LDS = OFF_XCH + 4 * 16384;
static_assert(ATT_LDS <= RING_BYTES && OFF_WS % 16 == 0 && SHM_BUF % 16 == 0 && SHM_K % 16 == 0, "attention LDS");
#define SBAR() __builtin_amdgcn_sched_barrier(0)
__device__ __forceinline__ int crow(int r, int hi) { return (r & 3) + 8 * (r >> 2) + 4 * hi; }
__device__ __forceinline__ int pk4_fp8(float a, float b, float c, float d) { int w = __builtin_amdgcn_cvt_pk_fp8_f32(a, b, 0, false); return __builtin_amdgcn_cvt_pk_fp8_f32(c, d, w, true); }
using epi::vpos;

template <bool PROMPT, int SDEPTH>
__device__ __forceinline__ void attn_unit(const unsigned char* Qw, const void* Kh, const void* Vh, const void* Kn, const void* Vn, int ncache, int NT,
                                          bool active, int c, int rb, int limit, float lam, const float* gsub, unsigned char* Ow, char* lds) {
  int tid = threadIdx.x; asm volatile("" : "+v"(tid));
  const int wid = __builtin_amdgcn_readfirstlane(tid >> 6), lane = tid & 63, r32 = lane & 31, hi = lane >> 5;
  char* B_lds = lds + OFF_BUF;
  float* ws = (float*)(lds + OFF_WS) + wid * 64; float* li_l = ws; float* al_l = ws + 32;
  float m_reg = -1e30f, l_reg = 0; f32x16 o[4] = {}; v8i qf = {};
  if (active) { const v4i* ql = (const v4i*)(Qw + (long)r32 * 1024 + hi * 32); const v4i q0 = ql[0], q1 = ql[1]; qf = __builtin_shufflevector(q0, q1, 0, 1, 2, 3, 4, 5, 6, 7); }
  struct SP_ { v4i ks, vs; }; struct SS_ { f32x8 ks0, ks1, vs0, vs1; };
  typename std::conditional<PROMPT, SP_, SS_>::type sr_[SDEPTH];
  unsigned gk0, gv0, lk0, lv0;
  if constexpr (PROMPT) { gk0 = (unsigned)((tid >> 3) * 1024 + (tid & 7) * 16); lk0 = (unsigned)((tid >> 3) * KPITCH + (tid & 7) * 16); gv0 = (unsigned)(tid * 16); lv0 = (unsigned)(SHM_K + (tid >> 2) * VPITCH + (tid & 3) * 16); }
  else { const int sr = tid >> 4, sc = (tid & 15) * 8; gk0 = (unsigned)((sr * 1024 + sc) * 4); gv0 = 0;
         lk0 = (unsigned)(sr * KPITCH + sc); lv0 = (unsigned)(SHM_K + sc * VPITCH + vpos(sr)); }
  asm volatile("" : "+v"(gk0), "+v"(gv0));
#define SLOAD(i, t) do { const int t_ = (t); \
    if constexpr (PROMPT) { const char* kp_ = (const char*)Kh + (long)t_ * (KVBLK * 1024); const char* vp_ = (const char*)Vh + (long)t_ * 8192; \
        sr_[i].ks = *reinterpret_cast<const v4i*>(kp_ + gk0); sr_[i].vs = *reinterpret_cast<const v4i*>(vp_ + gv0); } \
    else { const char* kp_ = t_ < ncache ? (const char*)Kh + (long)t_ * (KVBLK * 1024 * 4) : (const char*)Kn; const char* vp_ = t_ < ncache ? (const char*)Vh + (long)t_ * (KVBLK * 1024 * 4) : (const char*)Vn; \
        sr_[i].ks0 = *reinterpret_cast<const f32x8*>(kp_ + gk0); sr_[i].ks1 = *reinterpret_cast<const f32x8*>(kp_ + 32 * 1024 * 4 + gk0); sr_[i].vs0 = *reinterpret_cast<const f32x8*>(vp_ + gk0); sr_[i].vs1 = *reinterpret_cast<const f32x8*>(vp_ + 32 * 1024 * 4 + gk0); } } while (0)
#define CV8(x, s) { pk4_fp8(x[0] * s, x[1] * s, x[2] * s, x[3] * s), pk4_fp8(x[4] * s, x[5] * s, x[6] * s, x[7] * s) }
#define SWRITE(b, i) do { char* bb_ = B_lds + (b) * SHM_BUF; \
    if constexpr (PROMPT) { *reinterpret_cast<v4i*>(bb_ + lk0) = sr_[i].ks; *reinterpret_cast<v4i*>(bb_ + lv0) = sr_[i].vs; } \
    else { const int ka_[2] = CV8(sr_[i].ks0, SK), kb_[2] = CV8(sr_[i].ks1, SK); const int va_[2] = CV8(sr_[i].vs0, SV), vb_[2] = CV8(sr_[i].vs1, SV); \
        *reinterpret_cast<unsigned long long*>(bb_ + lk0) = (unsigned long long)(unsigned)ka_[0] | ((unsigned long long)(unsigned)ka_[1] << 32); \
        *reinterpret_cast<unsigned long long*>(bb_ + lk0 + 32 * KPITCH) = (unsigned long long)(unsigned)kb_[0] | ((unsigned long long)(unsigned)kb_[1] << 32); \
        _Pragma("unroll") for (int x_ = 0; x_ < 8; ++x_) { *reinterpret_cast<unsigned char*>(bb_ + lv0 + x_ * VPITCH) = (unsigned char)((unsigned)va_[x_ >> 2] >> (8 * (x_ & 3))); \
                                                           *reinterpret_cast<unsigned char*>(bb_ + lv0 + 16 + x_ * VPITCH) = (unsigned char)((unsigned)vb_[x_ >> 2] >> (8 * (x_ & 3))); } } } while (0)
#define SWAIT() do { if constexpr (SDEPTH == 2) asm volatile("s_waitcnt vmcnt(2)" ::: "memory"); else asm volatile("s_waitcnt vmcnt(0)" ::: "memory"); } while (0)
#define ONOPS() asm volatile("s_nop 15\n\ts_nop 15" ::: "memory")
#define RESC(a) do { if (__any((a) < 1.f)) { if (hi == 0) al_l[r32] = (a); asm volatile("s_waitcnt lgkmcnt(0)" ::: "memory"); SBAR(); ONOPS(); SBAR(); \
    _Pragma("unroll") for (int d = 0; d < 4; ++d) _Pragma("unroll") for (int r = 0; r < 16; ++r) o[d][r] *= al_l[crow(r, hi)]; SBAR(); asm volatile("s_nop 1" ::: "memory"); SBAR(); } } while (0)
  const char* Kr = B_lds + r32 * KPITCH + c * 64 + hi * 32;
  const char* Vr = B_lds + SHM_K + r32 * VPITCH + hi * 32;
#define LD8(p) ({ const v4i a_ = *reinterpret_cast<const v4i*>(p), b_ = *reinterpret_cast<const v4i*>((p) + 16); (v8i)__builtin_shufflevector(a_, b_, 0, 1, 2, 3, 4, 5, 6, 7); })
#define MFQK(Kf) __builtin_amdgcn_mfma_scale_f32_32x32x64_f8f6f4(Kf, qf, (f32x16){}, 0, 0, 0, 0, 0, 0)
#define MFPV(D0, Vf) asm volatile("s_nop 1\n\tv_mfma_f32_32x32x64_f8f6f4 %0, %1, %2, %0" : "+v"(o[D0]) : "v"(p8), "v"(Vf))
#define EX2(x) do { unsigned u_; asm("v_cvt_u32_f32 %0, %1" : "=v"(u_) : "v"(x)); x = __uint_as_float(u_); } while (0)
#define MX3(a, b, cc) __builtin_fmaxf(__builtin_fmaxf((a), (b)), (cc))
#define FM2(P, R) do { f32x2 t_ = {P[R], P[R + 1]}; t_ = __builtin_elementwise_fma(t_, c2_, m2_); P[R] = t_.x; P[R + 1] = t_.y; } while (0)
#define PHASE_A(N0, N1, O0, O1, alO, Kb) do { const char* kb_ = (Kb); f32x2 s2_; \
    SBAR(); const v8i k0_ = LD8(kb_), k1_ = LD8(kb_ + 32 * KPITCH); SBAR(); \
    N0 = MFQK(k0_); EX2(O1[8]); EX2(O1[9]); EX2(O1[10]); EX2(O1[11]); EX2(O1[12]); EX2(O1[13]); EX2(O1[14]); EX2(O1[15]); \
        p8[0] = pk4_fp8(O0[0] * SP, O0[1] * SP, O0[2] * SP, O0[3] * SP); p8[1] = pk4_fp8(O0[4] * SP, O0[5] * SP, O0[6] * SP, O0[7] * SP); \
        p8[2] = pk4_fp8(O0[8] * SP, O0[9] * SP, O0[10] * SP, O0[11] * SP); p8[3] = pk4_fp8(O0[12] * SP, O0[13] * SP, O0[14] * SP, O0[15] * SP); SBAR(); \
    N1 = MFQK(k1_); s2_ = (f32x2){O0[0], O0[1]}; _Pragma("unroll") for (int r_ = 2; r_ < 16; r_ += 2) s2_ += (f32x2){O0[r_], O0[r_ + 1]}; \
        _Pragma("unroll") for (int r_ = 0; r_ < 16; r_ += 2) s2_ += (f32x2){O1[r_], O1[r_ + 1]}; \
        { float ps_ = s2_.x + s2_.y; auto rr_ = __builtin_amdgcn_permlane32_swap(__float_as_uint(ps_), __float_as_uint(ps_), false, false); \
          ps_ = __uint_as_float(rr_[0]) + __uint_as_float(rr_[1]); l_reg = l_reg * (alO) + ps_; } \
        p8[4] = pk4_fp8(O1[0] * SP, O1[1] * SP, O1[2] * SP, O1[3] * SP); p8[5] = pk4_fp8(O1[4] * SP, O1[5] * SP, O1[6] * SP, O1[7] * SP); \
        p8[6] = pk4_fp8(O1[8] * SP, O1[9] * SP, O1[10] * SP, O1[11] * SP); p8[7] = pk4_fp8(O1[12] * SP, O1[13] * SP, O1[14] * SP, O1[15] * SP); SBAR(); } while (0)
#define PHASE_B(N0, N1, mnN, alN, Vb, tN) do { const char* vb_ = (Vb); const bool msk_ = (tN) >= limit; float ma_, mb_; f32x2 c2_, m2_; \
    SBAR(); const v8i v0_ = LD8(vb_), v1_ = LD8(vb_ + 32 * VPITCH); SBAR(); \
    MFPV(0, v0_); const v8i v2_ = LD8(vb_ + 64 * VPITCH); ma_ = MX3(N0[0], N0[1], N0[2]); mb_ = MX3(N1[0], N1[1], N1[2]); \
        _Pragma("unroll") for (int r_ = 3; r_ < 15; r_ += 2) { ma_ = MX3(ma_, N0[r_], N0[r_ + 1]); mb_ = MX3(mb_, N1[r_], N1[r_ + 1]); } ma_ = MX3(ma_, N0[15], N1[15]); ma_ = __builtin_fmaxf(ma_, mb_); \
        { auto rr_ = __builtin_amdgcn_permlane32_swap(__float_as_uint(ma_), __float_as_uint(ma_), false, false); ma_ = __builtin_fmaxf(__uint_as_float(rr_[0]), __uint_as_float(rr_[1])); } \
        ma_ = msk_ ? -1e30f : ma_; { const bool keep_ = __all(ma_ - m_reg <= THR_RAW); mnN = keep_ ? m_reg : __builtin_fmaxf(m_reg, ma_); } alN = __builtin_amdgcn_exp2f((m_reg - mnN) * CS); m_reg = mnN; \
        { const float ce_ = msk_ ? 0.f : CS * 8388608.0f, mc_ = msk_ ? -1e30f : (126.955f - mnN * CS) * 8388608.0f; c2_ = (f32x2){ce_, ce_}; m2_ = (f32x2){mc_, mc_}; } SBAR(); \
    MFPV(1, v1_); const v8i v3_ = LD8(vb_ + 96 * VPITCH); _Pragma("unroll") for (int r_ = 0; r_ < 16; r_ += 2) { FM2(N0, r_); FM2(N1, r_); } \
        EX2(N0[0]); EX2(N0[1]); EX2(N0[2]); EX2(N0[3]); SBAR(); \
    MFPV(2, v2_); _Pragma("unroll") for (int r_ = 4; r_ < 14; ++r_) EX2(N0[r_]); SBAR(); \
    MFPV(3, v3_); EX2(N0[14]); EX2(N0[15]); _Pragma("unroll") for (int r_ = 0; r_ < 8; ++r_) EX2(N1[r_]); SBAR(); } while (0)
#define SOFT_FIRST(N0, N1, mnN, alN, tN) do { const bool msk_ = (tN) >= limit; float ma_ = N0[0]; f32x2 c2_, m2_; \
    _Pragma("unroll") for (int r_ = 1; r_ < 16; ++r_) ma_ = __builtin_fmaxf(ma_, N0[r_]); _Pragma("unroll") for (int r_ = 0; r_ < 16; ++r_) ma_ = __builtin_fmaxf(ma_, N1[r_]); \
    { auto rr_ = __builtin_amdgcn_permlane32_swap(__float_as_uint(ma_), __float_as_uint(ma_), false, false); ma_ = __builtin_fmaxf(__uint_as_float(rr_[0]), __uint_as_float(rr_[1])); } \
    ma_ = msk_ ? -1e30f : ma_; { const bool keep_ = __all(ma_ - m_reg <= THR_RAW); mnN = keep_ ? m_reg : __builtin_fmaxf(m_reg, ma_); } alN = __builtin_amdgcn_exp2f((m_reg - mnN) * CS); m_reg = mnN; \
    { const float ce_ = msk_ ? 0.f : CS * 8388608.0f, mc_ = msk_ ? -1e30f : (126.955f - mnN * CS) * 8388608.0f; c2_ = (f32x2){ce_, ce_}; m2_ = (f32x2){mc_, mc_}; } \
    _Pragma("unroll") for (int r_ = 0; r_ < 16; r_ += 2) { FM2(N0, r_); FM2(N1, r_); } \
    _Pragma("unroll") for (int r_ = 0; r_ < 16; ++r_) EX2(N0[r_]); _Pragma("unroll") for (int r_ = 0; r_ < 8; ++r_) EX2(N1[r_]); } while (0)
#define QK_ONLY(N0, N1, Kb) do { const char* kb_ = (Kb); const v8i k0_ = LD8(kb_), k1_ = LD8(kb_ + 32 * KPITCH); N0 = MFQK(k0_); N1 = MFQK(k1_); } while (0)
#define FINISH_ONLY(O0, O1, alO) do { f32x2 s2_; _Pragma("unroll") for (int r_ = 8; r_ < 16; ++r_) EX2(O1[r_]); s2_ = (f32x2){O0[0], O0[1]}; \
    _Pragma("unroll") for (int r_ = 2; r_ < 16; r_ += 2) s2_ += (f32x2){O0[r_], O0[r_ + 1]}; _Pragma("unroll") for (int r_ = 0; r_ < 16; r_ += 2) s2_ += (f32x2){O1[r_], O1[r_ + 1]}; \
    { float ps_ = s2_.x + s2_.y; auto rr_ = __builtin_amdgcn_permlane32_swap(__float_as_uint(ps_), __float_as_uint(ps_), false, false); ps_ = __uint_as_float(rr_[0]) + __uint_as_float(rr_[1]); l_reg = l_reg * (alO) + ps_; } \
    _Pragma("unroll") for (int w_ = 0; w_ < 4; ++w_) { p8[w_] = pk4_fp8(O0[4 * w_] * SP, O0[4 * w_ + 1] * SP, O0[4 * w_ + 2] * SP, O0[4 * w_ + 3] * SP); p8[4 + w_] = pk4_fp8(O1[4 * w_] * SP, O1[4 * w_ + 1] * SP, O1[4 * w_ + 2] * SP, O1[4 * w_ + 3] * SP); } } while (0)
#define PV_ONLY(Vb) do { const char* vb_ = (Vb); const v8i v0_ = LD8(vb_), v1_ = LD8(vb_ + 32 * VPITCH), v2_ = LD8(vb_ + 64 * VPITCH), v3_ = LD8(vb_ + 96 * VPITCH); SBAR(); MFPV(0, v0_); MFPV(1, v1_); MFPV(2, v2_); MFPV(3, v3_); SBAR(); } while (0)
  f32x16 pA0 = {}, pA1 = {}, pB0 = {}, pB1 = {}; float mnA = 0.f, mnB = 0.f, alA = 1.f, alB = 1.f; v8i p8 = {};
  constexpr int SE = 0, SO = SDEPTH - 1;
  SLOAD(SE, 0); asm volatile("s_waitcnt vmcnt(0)" ::: "memory"); SWRITE(0, SE); __syncthreads();
  if (active) { QK_ONLY(pA0, pA1, Kr); SOFT_FIRST(pA0, pA1, mnA, alA, 0); }
  SLOAD(SO, 1); if constexpr (SDEPTH == 2) { if (2 < NT) SLOAD(SE, 2); }
  SWAIT(); SWRITE(1, SO); __syncthreads();
  int bc = 1;
  for (int j = 1; j + 1 < NT; j += 2) {
    { const int bp = bc == 0 ? 2 : bc - 1, bn = bc == 2 ? 0 : bc + 1;
      if (active) PHASE_A(pB0, pB1, pA0, pA1, alA, Kr + bc * SHM_BUF);
      SLOAD(SO, j + SDEPTH); SBAR();
      if (active) PHASE_B(pB0, pB1, mnB, alB, Vr + bp * SHM_BUF, j);
      SWAIT(); SWRITE(bn, SE);
      if (active) { RESC(alB); }
      __syncthreads(); bc = bn; }
    { const int bp = bc == 0 ? 2 : bc - 1, bn = bc == 2 ? 0 : bc + 1;
      if (active) PHASE_A(pA0, pA1, pB0, pB1, alB, Kr + bc * SHM_BUF);
      if (SDEPTH == 1 || j + 3 < NT) SLOAD(SE, j + 1 + SDEPTH); SBAR();
      if (active) PHASE_B(pA0, pA1, mnA, alA, Vr + bp * SHM_BUF, j + 1);
      SWAIT(); SWRITE(bn, SO);
      if (active) { RESC(alA); }
      __syncthreads(); bc = bn; }
  }
  { const int bp = bc == 0 ? 2 : bc - 1;
    if (active) { PHASE_A(pB0, pB1, pA0, pA1, alA, Kr + bc * SHM_BUF); PHASE_B(pB0, pB1, mnB, alB, Vr + bp * SHM_BUF, NT - 1);
      RESC(alB);
      FINISH_ONLY(pB0, pB1, alB); SBAR();
      PV_ONLY(Vr + bc * SHM_BUF); SBAR(); ONOPS(); SBAR(); } }
#undef PHASE_A
#undef PHASE_B
#undef SOFT_FIRST
#undef QK_ONLY
#undef FINISH_ONLY
#undef PV_ONLY
#undef LD8
#undef MFQK
#undef MFPV
#undef EX2
#undef MX3
#undef FM2
  float rli[16];
  if (active) {
    if (hi == 0) li_l[r32] = l_reg; asm volatile("s_waitcnt lgkmcnt(0)" ::: "memory");
#pragma unroll
    for (int r = 0; r < 16; ++r) rli[r] = __builtin_amdgcn_rcpf(li_l[crow(r, hi)]) * (1.0f / (SP * SV));
    if (c == 1) { float* x = (float*)(lds + OFF_XCH) + rb * 4096 + lane;
#pragma unroll
      for (int d0 = 0; d0 < 4; ++d0)
#pragma unroll
        for (int r = 0; r < 16; ++r) x[(d0 * 16 + r) * 64] = o[d0][r] * rli[r]; }
  }
  __syncthreads();
  if (active && c == 0) {
    const float* x = (const float*)(lds + OFF_XCH) + rb * 4096 + lane; float ss[16];
#pragma unroll
    for (int r = 0; r < 16; ++r) ss[r] = 0.f;
#pragma unroll
    for (int d0 = 0; d0 < 4; ++d0)
#pragma unroll
      for (int r = 0; r < 16; ++r) { const float v = o[d0][r] * rli[r] - lam * x[(d0 * 16 + r) * 64]; o[d0][r] = v; ss[r] += v * v; }
#pragma unroll
    for (int r = 0; r < 16; ++r) {
#pragma unroll
      for (int s = 1; s < 32; s <<= 1) ss[r] += __shfl_xor(ss[r], s);
      ss[r] = (1.0f - LAM_INIT) / sqrtf(ss[r] * (1.0f / VD) + RMS_EPS); }
    float gl[4];
#pragma unroll
    for (int d0 = 0; d0 < 4; ++d0) gl[d0] = gsub[d0 * 32 + r32];
#pragma unroll
    for (int r = 0; r < 16; ++r) { unsigned char* orow = Ow + (long)crow(r, hi) * DM + r32;
#pragma unroll
      for (int d0 = 0; d0 < 4; ++d0) { const float v = fminf(fmaxf(o[d0][r] * ss[r] * gl[d0] * epi::MIX_SCALE, -448.f), 448.f); orow[d0 * 32] = (unsigned char)(__builtin_amdgcn_cvt_pk_fp8_f32(v, v, 0, false) & 0xff); } }
  }
#undef SLOAD
#undef SWRITE
#undef SWAIT
#undef RESC
#undef CV8
#undef ONOPS
}
#undef SBAR
}

constexpr int TI_IN = (DM / 64) * (INW / 32), TI_GLU = (1024 / 64) * (2048 / 32), TI_OUT = (DM / 64) * (DM / 32), TI_FF1 = (DM / 64) * (DFF / 32), TI_FF2 = (DFF / 64) * (DM / 32);
constexpr int TI_ALL = TI_IN + TI_GLU + TI_OUT + TI_FF1 + TI_FF2;

__device__ __forceinline__ void xcd_skew(unsigned ticks) {
    if (ticks == 0u) return;
    const unsigned long long t0 = __builtin_amdgcn_s_memrealtime(); const unsigned long long w = (unsigned long long)(xb_xcc_id() & 7u) * ticks;
    while (__builtin_amdgcn_s_memrealtime() - t0 < w) __builtin_amdgcn_s_sleep(8);
}
#ifndef SKEW_IN
#define SKEW_IN 0
#endif
#ifndef SKEW_FF1
#define SKEW_FF1 0
#endif
#ifndef SKEW_FF2
#define SKEW_FF2 0
#endif
#ifndef SKEW_OUT
#define SKEW_OUT 0
#endif
template <class T> __device__ __forceinline__ T* launder_s(T* p) { asm volatile("" : "+s"(p)); return p; }
#define PHASE_LOCALS() int tid = threadIdx.x; asm volatile("" : "+v"(tid)); const int lane = tid & 63, wave = __builtin_amdgcn_readfirstlane(tid >> 6), gw = vcu * NWAVES + wave, NGW = G * NWAVES; \
    KA ka = (KA)__builtin_amdgcn_kernarg_segment_ptr(); asm volatile("" : "+s"(ka)); unsigned char* ws = ka->ws; float* out = ka->out; (void)ka; (void)lane; (void)gw; (void)NGW; (void)ws; (void)out
__global__ void __launch_bounds__(NWAVES * 64, 2) hymba_fwd(Args args) {
    extern __shared__ __attribute__((aligned(16))) unsigned char lds[];
    LAS unsigned char* L = (LAS unsigned char*)lds;
    const int G = gridDim.x, bx = blockIdx.x, vcu = (G % 8 == 0) ? (bx % 8) * (G / 8) + bx / 8 : bx;
    for (int u = threadIdx.x; u < (LDS_BYTES - LDSCTL_OFF) / 4; u += NWAVES * 64) ((LAS unsigned*)(L + LDSCTL_OFF))[u] = 0u;
    __syncthreads();
    XcdBarrier bar = xcd_barrier_post((unsigned*)(((KA)__builtin_amdgcn_kernarg_segment_ptr())->ws + WS_CTL) + CW_BAR, (volatile LAS unsigned*)(L + MISC_OFF) + 8);
#define GRID_BAR() xcd_barrier(bar)
#ifndef ATT_SPOS
#define ATT_SPOS(pu) ((pu) % 9)
#endif
#ifdef NO_SPLIT_TAIL
#define SLAB_ARG nullptr
#define TAIL_ORDER pg8::StaticOrder
#define TAIL_INIT(S, nt) S.init(M, DM, G, bx)
#else
#define SLAB_ARG (const float*)(ws + WS_SLAB)
#define TAIL_ORDER epi::SplitTailOrder
#define TAIL_INIT(S, nt) S.init(DM, G, bx, nt)
#endif
#ifndef PHM
#define PHM 0xFFFF
#endif
#ifndef REP_PHASE
#define REP_PHASE -1
#endif
#define PH(k) for (int rep_ = 0; rep_ < ((k) == REP_PHASE ? 2 : 1); ++rep_) if constexpr (((PHM) >> (k)) & 1)
    PH(0) { PHASE_LOCALS();
        float* MOD = (float*)(ws + WS_MOD);
        for (int job = bx; job < 256; job += G) {
            if (job < 192) skinny36_item<0>(ka, job, L, tid, wave, lane, nullptr, MOD);
            else s5_gen_group(ka, job - 192, L, tid, (bf16*)(ws + WS_BTM), (bf16*)(ws + WS_BTE), (float*)(ws + WS_A16));
        }
        __syncthreads();
        LAS float* scr = (LAS float*)(L + wave * 16384);
        for (int it = gw; it < TI_IN; it += NGW) { const int kb = it / (INW / 32), nb = it % (INW / 32); p0_transpose_item(ka->in[I_WIN], DM, INW, (bf16*)(ws + WS_WIN), nb * 32, scr, kb * 64, nb * 32, lane); }
        float* ROPE = (float*)(ws + WS_ROPE);
        for (int e = bx * 512 + tid; e < SEQ * 8; e += G * 512) {
            const int pos = e >> 3, i = e & 7;
            const float inv = (float)d_exp(-(double)i * 0.125 * 13.122363377404328);
            const float ang = (float)pos * inv; double sn, cs; d_sincos((double)ang, sn, cs);
            ROPE[pos * 16 + i] = (float)cs; ROPE[pos * 16 + 8 + i] = (float)sn;
        }
    }
    GRID_BAR();
    PH(1) { PHASE_LOCALS(); norm_mod_pass<0>(ka, (const float*)(ws + WS_MOD), out + O_Y, nullptr, (bf16*)(ws + WS_H), gw, NGW, lane);
        for (int r = gw; r < 64; r += NGW) { bf16* dst = (bf16*)(ws + WS_SHB) + (size_t)r * DM; const float* src = (const float*)(ws + WS_MOD) + (size_t)(r < NMOD ? r : 0) * MODW + 3 * DM;
            for (int c0 = lane; c0 < DM; c0 += 64) dst[c0] = r < NMOD ? (bf16)f2bf(src[c0]) : (bf16)0; } }
    GRID_BAR();
    PH(2) { PHASE_LOCALS();
        pg8::Gemm g{(bf16*)(ws + WS_H), (bf16*)(ws + WS_WIN), DM, DM, DM}; pg8::StaticOrder S; S.init(M, INW, G, bx);
        epi::EpiInProj E{ws + WS_Q, ws + WS_K, ws + WS_V, (bf16*)(ws + WS_UR), out, (const float*)(ws + WS_ROPE)};
        xcd_skew(SKEW_IN);
        pg8::gemm_phase<epi::EpiInProj, pg8::StaticOrder, true, true>(L, g, S, E);
        { const int nidle = G - (M / 256 * (INW / 256) - 8 * G); if (nidle > 0 && bx >= G - nidle) {
            __syncthreads(); LAS float* scr = (LAS float*)(L + wave * 16384); const int iw = (bx - (G - nidle)) * NWAVES + wave, niw = nidle * NWAVES;
            for (int it = iw; it < TI_ALL - TI_IN; it += niw) {
                int r = it;
                if (r < TI_GLU) { const int kb = r / 64, nb = r % 64, n0 = nb * 32; const int wrow0 = n0 < 1024 ? (n0 >> 7) * 256 + (n0 & 127) : ((n0 - 1024) >> 7) * 256 + 128 + (n0 & 127);
                    p0_transpose_item8(ka->in[I_WGLU], 1024, 2048, ws + WS_WGLU, wrow0, scr, kb * 64, n0, lane, epi::WGLU_SCALE); continue; } r -= TI_GLU;
                if (r < TI_OUT) { const int kb = r / (DM / 32), nb = r % (DM / 32); p0_transpose_item8(ka->in[I_WOUT], DM, DM, ws + WS_WOUT, nb * 32, scr, kb * 64, nb * 32, lane, epi::WOUT_SCALE); continue; } r -= TI_OUT;
                if (r < TI_FF1) { const int kb = r / (DFF / 32), nb = r % (DFF / 32); p0_transpose_item(ka->in[I_WFF1], DM, DFF, (bf16*)(ws + WS_WFF1), nb * 32, scr, kb * 64, nb * 32, lane); continue; } r -= TI_FF1;
                { const int kb = r / (DM / 32), nb = r % (DM / 32); p0_transpose_item8(ka->in[I_WFF2], DFF, DM, ws + WS_WFF2, nb * 32, scr, kb * 64, nb * 32, lane, epi::W2_SCALE); }
            } } }
    }
    GRID_BAR();
    PH(3) { PHASE_LOCALS();
        pg8::Gemm g{(bf16*)(ws + WS_UR), (bf16*)(ws + WS_BTE), S5K, 256, 256}; epi::S5Order S{G, bx};
        epi::EpiS5E E{(float*)(ws + WS_E)};
        pg8::gemm_phase<epi::EpiS5E, epi::S5Order, true, true>(L, g, S, E);
    }
    GRID_BAR();
    PH(4) { PHASE_LOCALS(); carry_scan(ka, (const float*)(ws + WS_E), (bf16*)(ws + WS_UR), (const float*)(ws + WS_A16), out, L, vcu, G, wave, lane);
    }
    GRID_BAR();
    PH(5) { PHASE_LOCALS();
        pg8::Gemm g{(bf16*)(ws + WS_UR), (bf16*)(ws + WS_BTM), S5K, S5K, S5K}; epi::S5Order S{G, bx};
        epi::EpiS5Main E{ws + WS_Z};
        pg8::gemm_phase<epi::EpiS5Main, epi::S5Order, true, true>(L, g, S, E);
    }
    PH(6) { PHASE_LOCALS();
        const unsigned char *Q8 = ws + WS_Q, *K8 = ws + WS_K, *VT8 = ws + WS_V; unsigned char* MIX = ws + WS_MIX;
        float lam;
        { const float a1 = wave_sum(ka->in[I_LQ1][lane] * ka->in[I_LK1][lane]), a2 = wave_sum(ka->in[I_LQ2][lane] * ka->in[I_LK2][lane]); lam = __expf(a1) - __expf(a2) + LAM_INIT; }
        const float* gsub = ka->in[I_GSUB];
        for (int pu = vcu; pu < NBP * NH * 8; pu += G) {
            const int bh = pu >> 3, s = pu & 7, b = bh >> 3, h = bh & 7; const int spos = ATT_SPOS(pu);
            int i = 0;
            for (int slot = 0; slot < 9; ++slot) {
                if (slot == spos) {
                    const int bs = pu >> 3, hs = pu & 7; const bool active = wave < 4; const int c = (wave >> 1) & 1, rb = wave & 1;
                    const size_t qrow = (size_t)MP + bs * DSEQ + rb * 32;
                    att::attn_unit<false, 1>(Q8 + qrow * AW + hs * 128 + c * 64,
                                             ka->in[I_CK] + (size_t)bs * PAST * AW + hs * 128, ka->in[I_CV] + (size_t)bs * PAST * AW + hs * 128,
                                             out + O_KS + (size_t)bs * DSEQ * AW + hs * 128, out + O_VS + (size_t)bs * DSEQ * AW + hs * 128,
                                             PAST / 64, PAST / 64 + 2, active, c, rb, PAST / 64 + 1, lam, gsub, MIX + qrow * DM + hs * 128, (char*)lds);
                } else {
                    const int c = wave >> 2, rb = wave & 3;
                    const int qb2 = (i >> 1) * 16 + ((i & 1) ? 15 - s : s); ++i;
                    const size_t qrow = (size_t)b * SEQ + qb2 * 128 + rb * 32;
                    const unsigned char* Kh = K8 + (size_t)b * SEQ * AW + h * 128; const unsigned char* Vh = VT8 + (size_t)bh * (SEQ / 64) * 8192;
                    att::attn_unit<true, 2>(Q8 + qrow * AW + h * 128 + c * 64, Kh, Vh, Kh, Vh, 2 * qb2 + 2, 2 * qb2 + 2, true, c, rb, 2 * qb2 + (rb >> 1) + 1, lam, gsub, MIX + qrow * DM + h * 128, (char*)lds);
                }
            }
        }
    }
    GRID_BAR();
    PH(7) { PHASE_LOCALS();
        pg8::Gemm g{(bf16*)(ws + WS_Z), (bf16*)(ws + WS_WGLU), 1024, 1024, 1024}; pg8::StaticOrder S; S.init(M, 2048, G, bx);
        epi::EpiGlu E{ws + WS_MIX, ka->in[I_BGLU]};
        pg8::gemm_phase<epi::EpiGlu, pg8::StaticOrder, true, true, true>(L, g, S, E);
    }
    GRID_BAR();
    PH(8) { PHASE_LOCALS();
        pg8::Gemm g{(bf16*)(ws + WS_MIX), (bf16*)(ws + WS_WOUT), DM, DM, DM}; pg8::StaticOrder S; S.init(M, DM, G, bx);
        epi::EpiOut E{ka->in[I_XP], ka->in[I_XS], (bf16*)(ws + WS_H), (float*)(ws + WS_STAT), (const float*)(ws + WS_MOD), ka->in[I_GFFN]};
        xcd_skew(SKEW_OUT);
        pg8::gemm_phase<epi::EpiOut, pg8::StaticOrder, true, true, true>(L, g, S, E);
        { const int nbusy = M / 256 * (DM / 256) - 4 * G, nidle = G - nbusy; if (nbusy > 0 && nidle > 0 && bx >= nbusy) {
            __syncthreads();
            for (int job = bx - nbusy; job < DFF / 32; job += nidle) c2_mfma_item(job, (const bf16*)(ws + WS_SHB), (const bf16*)(ws + WS_WFF1), (float*)(ws + WS_C2), L, wave, lane); } }
    }
    GRID_BAR();
    PH(10) { PHASE_LOCALS();
        pg8::Gemm g{(bf16*)(ws + WS_H), (bf16*)(ws + WS_WFF1), DM, DM, DM}; pg8::StaticOrder S; S.init(M, DFF, G, bx);
        epi::EpiFF1 E{ws + WS_HID, (const float*)(ws + WS_STAT), (const float*)(ws + WS_C2)};
        xcd_skew(SKEW_FF1);
        pg8::gemm_phase<epi::EpiFF1, pg8::StaticOrder, true, true>(L, g, S, E);
    }
    GRID_BAR();
    PH(11) { PHASE_LOCALS();
        pg8::Gemm g{(bf16*)(ws + WS_HID), (bf16*)(ws + WS_WFF2), DFF, DFF, DFF}; TAIL_ORDER S; TAIL_INIT(S, DFF / 128);
        epi::EpiFF2 E{(bf16*)(ws + WS_X2), (const float*)(ws + WS_MOD), (float*)(ws + WS_SLAB), (const bf16*)(ws + WS_H), ka->in[I_GFFN]};
        xcd_skew(SKEW_FF2);
        pg8::gemm_phase<epi::EpiFF2, TAIL_ORDER, true, true, true>(L, g, S, E);
    }
    GRID_BAR();
    PH(12) { PHASE_LOCALS(); final_norm_pass(ka, out + O_Y, (const bf16*)(ws + WS_X2), SLAB_ARG, gw, NGW, lane); }
#undef GRID_BAR
}

extern "C" void kernel_launch(void* const* d_in, const int* in_sizes, int n_in, void* d_out, int out_size, void* d_ws, size_t ws_size, hipStream_t stream) {
    static int grid = 0;
    if (grid == 0) {
        if (n_in != N_IN || (size_t)out_size != O_END || ws_size < WS_END) { fprintf(stderr, "kernel_launch: shape mismatch: n_in %d out %d ws %zu (need %d, %zu, >= %zu); nothing launched\n", n_in, out_size, ws_size, (int)N_IN, (size_t)O_END, (size_t)WS_END); grid = -1; return; }
        int dev = 0, cus = 0, per_cu = 0;
        if (hipGetDevice(&dev) != hipSuccess || hipDeviceGetAttribute(&cus, hipDeviceAttributeMultiprocessorCount, dev) != hipSuccess) { fprintf(stderr, "kernel_launch: device query failed\n"); grid = -1; return; }
        if (hipFuncSetAttribute((const void*)hymba_fwd, hipFuncAttributeMaxDynamicSharedMemorySize, LDS_BYTES) != hipSuccess) { fprintf(stderr, "kernel_launch: hipFuncSetAttribute failed\n"); grid = -1; return; }
        if (hipOccupancyMaxActiveBlocksPerMultiprocessor(&per_cu, (const void*)hymba_fwd, NWAVES * 64, LDS_BYTES) != hipSuccess || per_cu < 1) { fprintf(stderr, "kernel_launch: occupancy query reports %d workgroups per CU\n", per_cu); }
        (void)hipGetLastError();
        grid = cus;
    }
    if (grid < 0) return;
    if (hipMemsetAsync((char*)d_ws + WS_CTL, 0, CTL_ZERO_BYTES, stream) != hipSuccess) { fprintf(stderr, "kernel_launch: memset failed\n"); return; }
    Args a{};
    for (int i = 0; i < N_IN; ++i) a.in[i] = (const float*)d_in[i];
    a.out = (float*)d_out; a.ws = (unsigned char*)d_ws;
    hipLaunchKernelGGL(hymba_fwd, dim3(grid), dim3(NWAVES * 64), LDS_BYTES, stream, a);
    const hipError_t le = hipPeekAtLastError();
    if (le != hipSuccess) fprintf(stderr, "kernel_launch: launch failed: %s\n", hipGetErrorName(le));
}
```
